# Optimizing an MI355X kernel written in HIP

```python
import math
import jax, jax.numpy as jnp
from jax import lax
import numpy as np

D_MODEL = 1024
BATCH = 2
SEQ = 16384
DEPTH = 2

HEAD_DIM = 64
MOBA_HEADS = 8
MOBA_BLOCK = 256
MOBA_TOPK = 3
MOBA_Q_CHUNK = 64
DIL_HEADS = 8
DIL_PATTERNS = ((128, 1), (512, 4), (2048, 16))
POOL_WINDOWS = (2, 4, 8, 16)
POOL_GROUPS = 4
POOL_WIDTH = 512
POOL_GROUP_DIM = POOL_WIDTH // POOL_GROUPS

N_BRANCH = 3
D_A = MOBA_HEADS * HEAD_DIM
D_B = DIL_HEADS * HEAD_DIM
D_FF = 4 * D_MODEL
IN_WIDTHS = (D_A, D_A, D_A, D_B, D_B, D_B, POOL_WIDTH, N_BRANCH * D_MODEL)
IN_COLS = 3 * D_A + 3 * D_B + POOL_WIDTH + N_BRANCH * D_MODEL
RMS_EPS = 1e-6

kernel_name = "hybrid_moba_dilated_pool_gated_block"


def rmsnorm(x, g):
    xf = x.astype(jnp.float32)
    var = jnp.mean(xf * xf, axis=-1, keepdims=True)
    return (xf * lax.rsqrt(var + RMS_EPS)).astype(x.dtype) * g


def split_heads(t, n_heads):
    b, s, _ = t.shape
    return t.reshape(b, s, n_heads, HEAD_DIM).transpose(0, 2, 1, 3)


def merge_heads(t):
    b, h, s, hd = t.shape
    return t.transpose(0, 2, 1, 3).reshape(b, s, h * hd)


def moba_attention(q, k, v):
    b, h, s, hd = q.shape
    nb = -(-s // MOBA_BLOCK)
    pad = nb * MOBA_BLOCK - s
    kp = jnp.pad(k, ((0, 0), (0, 0), (0, pad), (0, 0)))
    vp = jnp.pad(v, ((0, 0), (0, 0), (0, pad), (0, 0)))
    kb = kp.reshape(b, h, nb, MOBA_BLOCK, hd)
    vb = vp.reshape(b, h, nb, MOBA_BLOCK, hd)
    kbar = jnp.mean(kb.astype(jnp.float32), axis=3).astype(k.dtype)
    topk = min(MOBA_TOPK, nb)
    scale = HEAD_DIM ** -0.5
    n_chunks = s // MOBA_Q_CHUNK
    qc = q.reshape(b, h, n_chunks, MOBA_Q_CHUNK, hd).transpose(2, 0, 1, 3, 4)
    bi = jnp.arange(b)[:, None, None, None]
    hi = jnp.arange(h)[None, :, None, None]
    n_sel = topk * MOBA_BLOCK

    def one_chunk(args):
        c, qb = args
        start = c * MOBA_Q_CHUNK
        blk = start // MOBA_BLOCK
        gs = jnp.einsum('bhqd,bhnd->bhqn', qb, kbar).astype(jnp.float32)
        gs = jnp.where(jnp.arange(nb) < blk, gs, -jnp.inf)
        _, gidx = lax.top_k(gs, topk)
        valid = gidx < blk
        kg = kb[bi, hi, gidx]
        vg = vb[bi, hi, gidx]
        s_sel = jnp.einsum('bhqd,bhqjkd->bhqjk', qb, kg).astype(jnp.float32) * scale
        s_sel = jnp.where(valid[..., None], s_sel, -jnp.inf).reshape(b, h, MOBA_Q_CHUNK, n_sel)
        k_own = lax.dynamic_slice_in_dim(kp, blk * MOBA_BLOCK, MOBA_BLOCK, axis=2)
        v_own = lax.dynamic_slice_in_dim(vp, blk * MOBA_BLOCK, MOBA_BLOCK, axis=2)
        s_own = jnp.einsum('bhqd,bhkd->bhqk', qb, k_own).astype(jnp.float32) * scale
        qpos = start + jnp.arange(MOBA_Q_CHUNK)
        kpos = blk * MOBA_BLOCK + jnp.arange(MOBA_BLOCK)
        s_own = jnp.where(kpos[None, :] <= qpos[:, None], s_own, -jnp.inf)
        p = jax.nn.softmax(jnp.concatenate([s_sel, s_own], axis=-1), axis=-1).astype(v.dtype)
        p_sel = p[..., :n_sel].reshape(b, h, MOBA_Q_CHUNK, topk, MOBA_BLOCK)
        o = (jnp.einsum('bhqjk,bhqjkd->bhqd', p_sel, vg)
             + jnp.einsum('bhqk,bhkd->bhqd', p[..., n_sel:], v_own))
        return o

    o = lax.map(one_chunk, (jnp.arange(n_chunks), qc))
    return o.transpose(1, 2, 0, 3, 4).reshape(b, h, s, hd)


def dilated_pattern(q, k, v, window, dilation):
    b, h, s, hd = q.shape
    band = window // dilation
    L = s // dilation
    nb = -(-L // band)
    Lp = nb * band
    scale = HEAD_DIM ** -0.5

    def strided(t):
        t = t.reshape(b, h, L, dilation, hd).transpose(0, 1, 3, 2, 4)
        t = jnp.pad(t, ((0, 0), (0, 0), (0, 0), (0, Lp - L), (0, 0)))
        return t.reshape(b, h, dilation, nb, band, hd)

    def with_prev(t):
        prev = jnp.pad(t, ((0, 0), (0, 0), (0, 0), (1, 0), (0, 0), (0, 0)))[:, :, :, :-1]
        return jnp.concatenate([prev, t], axis=4)

    qs = strided(q)
    kw = with_prev(strided(k))
    vw = with_prev(strided(v))
    sc = jnp.einsum('bhrnqd,bhrnkd->bhrnqk', qs, kw).astype(jnp.float32) * scale
    i = jnp.arange(band)[:, None]
    j = jnp.arange(2 * band)[None, :]
    dist = band + i - j
    blk = jnp.arange(nb)[:, None, None]
    ok = (dist >= 0) & (dist <= band) & ((blk > 0) | (j >= band))
    sc = jnp.where(ok, sc, -jnp.inf)
    lse = jax.nn.logsumexp(sc, axis=-1)
    p = jnp.exp(sc - lse[..., None]).astype(v.dtype)
    o = jnp.einsum('bhrnqk,bhrnkd->bhrnqd', p, vw)
    o = o.reshape(b, h, dilation, Lp, hd)[:, :, :, :L].transpose(0, 1, 3, 2, 4).reshape(b, h, s, hd)
    lse = lse.reshape(b, h, dilation, Lp)[:, :, :, :L].transpose(0, 1, 3, 2).reshape(b, h, s)
    return o, lse


def dilated_attention(q, k, v):
    outs, lses = [], []
    for window, dilation in DIL_PATTERNS:
        o, lse = dilated_pattern(q, k, v, window, dilation)
        outs.append(o)
        lses.append(lse)
    wts = jax.nn.softmax(jnp.stack(lses, axis=0), axis=0).astype(q.dtype)
    return jnp.einsum('pbhs,pbhsd->bhsd', wts, jnp.stack(outs, axis=0))


def pool_mixer(u, w_pool, pool_scale):
    b, s, _ = u.shape
    ug = u.reshape(b, s, POOL_GROUPS, POOL_GROUP_DIM).astype(jnp.float32)
    cs = jnp.pad(jnp.cumsum(ug, axis=1), ((0, 0), (1, 0), (0, 0), (0, 0)))
    t = jnp.arange(s)
    pooled = []
    for g, w in enumerate(POOL_WINDOWS):
        csg = cs[:, :, g]
        lower = jnp.pad(csg, ((0, 0), (w - 1, 0), (0, 0)))[:, :s]
        cnt = jnp.minimum(t + 1, w).astype(jnp.float32)
        pooled.append((csg[:, 1:] - lower) / cnt[None, :, None])
    pooled = jnp.stack(pooled, axis=2) - ug
    y = jnp.einsum('bsgc,gcd->bsgd', pooled.astype(u.dtype), w_pool)
    return y.reshape(b, s, POOL_WIDTH) * pool_scale


def hybrid_layer(x, w_in, w_br_a, w_br_b, w_br_c, w_out, w_pool, pool_scale,
                 g_pre_mix, g_post_mix, g_pre_mlp, g_post_mlp, w_ff1, w_ff2):
    b, s, _ = x.shape
    h = rmsnorm(x, g_pre_mix)
    z = h @ w_in
    offsets = list(np.cumsum(IN_WIDTHS)[:-1])
    qa, ka, va, qb, kb, vb, uc, gz = jnp.split(z, offsets, axis=-1)
    oa = merge_heads(moba_attention(split_heads(qa, MOBA_HEADS), split_heads(ka, MOBA_HEADS),
                                    split_heads(va, MOBA_HEADS)))
    ob = merge_heads(dilated_attention(split_heads(qb, DIL_HEADS), split_heads(kb, DIL_HEADS),
                                       split_heads(vb, DIL_HEADS)))
    oc = pool_mixer(uc, w_pool, pool_scale)
    gates = jax.nn.sigmoid(gz.reshape(b, s, N_BRANCH, D_MODEL))
    merged = (gates[:, :, 0] * (oa @ w_br_a)
              + gates[:, :, 1] * (ob @ w_br_b)
              + gates[:, :, 2] * (oc @ w_br_c))
    x = x + rmsnorm(merged @ w_out, g_post_mix)
    hm = rmsnorm(x, g_pre_mlp)
    y = jnp.square(jax.nn.relu(hm @ w_ff1)) @ w_ff2
    return x + rmsnorm(y, g_post_mlp)


def setup_inputs(seed: int = 0) -> dict:
    key = jax.random.key(seed)
    ks = jax.random.split(key, 16)
    f32 = jnp.float32

    def nrm(k, shape, fan_in):
        return jax.random.normal(k, shape, f32) * (fan_in ** -0.5)

    return {
        "x": jax.random.normal(ks[0], (BATCH, SEQ, D_MODEL), f32),
        "w_in": nrm(ks[1], (DEPTH, D_MODEL, IN_COLS), D_MODEL),
        "w_br_a": nrm(ks[2], (DEPTH, D_A, D_MODEL), D_A),
        "w_br_b": nrm(ks[3], (DEPTH, D_B, D_MODEL), D_B),
        "w_br_c": nrm(ks[4], (DEPTH, POOL_WIDTH, D_MODEL), POOL_WIDTH),
        "w_out": nrm(ks[5], (DEPTH, D_MODEL, D_MODEL), D_MODEL),
        "w_pool": nrm(ks[6], (DEPTH, POOL_GROUPS, POOL_GROUP_DIM, POOL_GROUP_DIM), POOL_GROUP_DIM),
        "pool_scale": 0.5 + 0.1 * jax.random.normal(ks[7], (DEPTH, POOL_WIDTH), f32),
        "g_pre_mix": 1.0 + 0.05 * jax.random.normal(ks[8], (DEPTH, D_MODEL), f32),
        "g_post_mix": 1.0 + 0.05 * jax.random.normal(ks[9], (DEPTH, D_MODEL), f32),
        "g_pre_mlp": 1.0 + 0.05 * jax.random.normal(ks[10], (DEPTH, D_MODEL), f32),
        "g_post_mlp": 1.0 + 0.05 * jax.random.normal(ks[11], (DEPTH, D_MODEL), f32),
        "w_ff1": nrm(ks[12], (DEPTH, D_MODEL, D_FF), D_MODEL),
        "w_ff2": nrm(ks[13], (DEPTH, D_FF, D_MODEL), D_FF),
    }


def reference(x, w_in, w_br_a, w_br_b, w_br_c, w_out, w_pool, pool_scale,
              g_pre_mix, g_post_mix, g_pre_mlp, g_post_mlp, w_ff1, w_ff2):
    for l in range(DEPTH):
        x = hybrid_layer(x, w_in[l], w_br_a[l], w_br_b[l], w_br_c[l], w_out[l], w_pool[l],
                         pool_scale[l], g_pre_mix[l], g_post_mix[l], g_pre_mlp[l], g_post_mlp[l],
                         w_ff1[l], w_ff2[l])
    return x
```

```cpp
#include <hip/hip_runtime.h>
#include <cstdio>
#include <cstdint>
#include <cmath>
namespace pg8 {
#define PG8_LAS __attribute__((address_space(3)))
typedef unsigned short bf16_t;
typedef short bf16x8 __attribute__((ext_vector_type(8)));
typedef float f32x4 __attribute__((ext_vector_type(4)));
typedef unsigned u32x4 __attribute__((ext_vector_type(4)));
constexpr int BM = 256, BK = 64, HALF = 128, HTB = HALF * BK * 2  , STAGE_BYTES = 8 * HTB, NXCD = 8, WGM = 8;

__host__ __device__ __forceinline__ int lds_byte(int r, int c) { const int st = (r >> 4) * 2 + (c >> 5), rr = r & 15, cc = c & 31, ob = rr * 64 + cc * 2; return st * 1024 + (ob ^ (((ob >> 9) & 1) << 5)); }
__host__ __device__ __forceinline__ void stage_rc(int b, int& R, int& C) { const int st = b / 1024, sb = b % 1024, swz = sb ^ (((sb >> 9) & 1) << 5); R = (st >> 1) * 16 + swz / 64; C = (st & 1) * 32 + (swz % 64) / 2; }
__host__ __device__ __forceinline__ int perm32(int rho) { const int n = rho >> 4, i = rho & 15; return 8 * (i >> 2) + 4 * n + (i & 3); }

struct Unit { int pm, pn; };
struct Gemm { const bf16_t* A; const bf16_t* Bt; int M, N, K; };

struct StaticOrder {
    int nM, nN, nwg, G, c;
    __host__ __device__ void init(int M, int N, int G_, int c_) { nM = M / BM; nN = N / BM; nwg = nM * nN; G = G_; c = c_; }
    __host__ __device__ bool next(int i, Unit& u) const {
        const long L = (long)i * G + c; if (L >= nwg) return false;
        int wgid = (int)L; { const int q = nwg / NXCD, r = nwg % NXCD, xcd = wgid % NXCD, off = wgid / NXCD; wgid = (xcd < r ? xcd * (q + 1) : r * (q + 1) + (xcd - r) * q) + off; }
        const int nig = WGM * nN, gid = wgid / nig, fm = gid * WGM, gsz = (nM - fm) < WGM ? (nM - fm) : WGM;
        u.pm = fm + ((wgid % nig) % gsz); u.pn = (wgid % nig) / gsz; return true;
    }
    __device__ __forceinline__ void a_ready(const Unit&) const {}
    __device__ __forceinline__ void done(const Unit&) const {}
};

__device__ __forceinline__ unsigned cvt_pk_bf16(float lo, float hi) { unsigned r; asm volatile("v_cvt_pk_bf16_f32 %0, %1, %2" : "=v"(r) : "v"(lo), "v"(hi)); return r; }
typedef float f32x2 __attribute__((ext_vector_type(2)));
typedef unsigned u32x2 __attribute__((ext_vector_type(2)));
constexpr float kC2 = 0.125f * 1.4426950408889634f;

__device__ __forceinline__ unsigned sig_u8(float z) {
    const float g = __builtin_amdgcn_rcpf(1.0f + __builtin_amdgcn_exp2f(-1.4426950408889634f * z));
    float q = __builtin_rintf(g * 255.0f); q = q < 1.0f ? 1.0f : (q > 255.0f ? 255.0f : q);
    return (unsigned)q;
}
struct EpiIn {
    static constexpr bool PERM = true, AFTER_DRAIN = false, HAS_MID = false;
    bf16_t* X1; bf16_t* UC; bf16_t* X2; unsigned char* G;
    __device__ __forceinline__ void mid(f32x4 (&)[2][2][4][2], const Unit&, int, int, int, int, int) const {}
    __device__ __forceinline__ void operator()(const f32x4 (&acc)[2][2][4][2], const Unit& u, int wr, int wc, int fr, int fq) const {
        const int row0 = u.pm * BM + wr * 64 + fr, pn = u.pn;
        if (pn < 14) {
            bf16_t* base; int ldc, colt; float sc = 1.0f;
            if (pn < 4) { base = X1; ldc = 1536; colt = pn * BM; sc = kC2; }
            else if (pn < 6) { base = UC; ldc = 512; colt = (pn - 4) * BM; }
            else { base = X2; ldc = 2048; colt = (pn - 6) * BM; }
            const int col0 = colt + wc * 32 + 8 * fq;
#pragma unroll
            for (int ai = 0; ai < 2; ++ai)
#pragma unroll
                for (int m = 0; m < 4; ++m) { bf16_t* rowp = base + (size_t)(row0 + ai * HALF + m * 16) * ldc + col0;
#pragma unroll
                    for (int bj = 0; bj < 2; ++bj) { const f32x4 v0 = acc[ai][bj][m][0] * sc, v1 = acc[ai][bj][m][1] * sc;
                        u32x4 w; w.x = cvt_pk_bf16(v0[0], v0[1]); w.y = cvt_pk_bf16(v0[2], v0[3]); w.z = cvt_pk_bf16(v1[0], v1[1]); w.w = cvt_pk_bf16(v1[2], v1[3]);
                        *(u32x4*)(rowp + bj * HALF) = w; } }
        } else {
            const int col0 = (pn - 14) * BM + wc * 32 + 8 * fq;
#pragma unroll
            for (int ai = 0; ai < 2; ++ai)
#pragma unroll
                for (int m = 0; m < 4; ++m) { unsigned char* rowp = G + (size_t)(row0 + ai * HALF + m * 16) * 3072 + col0;
#pragma unroll
                    for (int bj = 0; bj < 2; ++bj) { const f32x4 v0 = acc[ai][bj][m][0], v1 = acc[ai][bj][m][1];
                        u32x2 w; w.x = sig_u8(v0[0]) | (sig_u8(v0[1]) << 8) | (sig_u8(v0[2]) << 16) | (sig_u8(v0[3]) << 24);
                        w.y = sig_u8(v1[0]) | (sig_u8(v1[1]) << 8) | (sig_u8(v1[2]) << 16) | (sig_u8(v1[3]) << 24);
                        *(u32x2*)(rowp + bj * HALF) = w; } }
        }
    }
};
struct EpiMerge {
    static constexpr bool PERM = true, AFTER_DRAIN = false, HAS_MID = true;
    const unsigned char* G; bf16_t* O;
    __device__ __forceinline__ void mid(f32x4 (&acc)[2][2][4][2], const Unit& u, int seg, int wr, int wc, int fr, int fq) const {
        int row0 = u.pm * BM + wr * 64 + fr, col0 = u.pn * BM + wc * 32 + 8 * fq;
        asm volatile("" : "+v"(row0), "+v"(col0));
#pragma unroll
        for (int ai = 0; ai < 2; ++ai)
#pragma unroll
            for (int m = 0; m < 4; ++m) { const unsigned char* rowp = G + (size_t)(row0 + ai * HALF + m * 16) * 3072 + col0;
#pragma unroll
                for (int bj = 0; bj < 2; ++bj) {
                    const u32x2 ga = *(const u32x2*)(rowp + (seg - 1) * 1024 + bj * HALF), gb = *(const u32x2*)(rowp + seg * 1024 + bj * HALF);
                    f32x4 r0, r1;
#pragma unroll
                    for (int j = 0; j < 4; ++j) { r0[j] = (float)((ga.x >> (8 * j)) & 255u) * __builtin_amdgcn_rcpf((float)((gb.x >> (8 * j)) & 255u));
                                                  r1[j] = (float)((ga.y >> (8 * j)) & 255u) * __builtin_amdgcn_rcpf((float)((gb.y >> (8 * j)) & 255u)); }
                    acc[ai][bj][m][0] *= r0; acc[ai][bj][m][1] *= r1; }
                asm volatile("" ::: "memory"); }
    }
    __device__ __forceinline__ void operator()(const f32x4 (&acc)[2][2][4][2], const Unit& u, int wr, int wc, int fr, int fq) const {
        const int row0 = u.pm * BM + wr * 64 + fr, col0 = u.pn * BM + wc * 32 + 8 * fq;
#pragma unroll
        for (int ai = 0; ai < 2; ++ai)
#pragma unroll
            for (int m = 0; m < 4; ++m) { const size_t r = (size_t)(row0 + ai * HALF + m * 16);
#pragma unroll
                for (int bj = 0; bj < 2; ++bj) {
                    const u32x2 gc = *(const u32x2*)(G + r * 3072 + 2048 + col0 + bj * HALF);
                    f32x4 v0 = acc[ai][bj][m][0], v1 = acc[ai][bj][m][1];
#pragma unroll
                    for (int j = 0; j < 4; ++j) { v0[j] *= (float)((gc.x >> (8 * j)) & 255u) * (1.0f / 255.0f); v1[j] *= (float)((gc.y >> (8 * j)) & 255u) * (1.0f / 255.0f); }
                    u32x4 w; w.x = cvt_pk_bf16(v0[0], v0[1]); w.y = cvt_pk_bf16(v0[2], v0[3]); w.z = cvt_pk_bf16(v1[0], v1[1]); w.w = cvt_pk_bf16(v1[2], v1[3]);
                    *(u32x4*)(O + r * 1024 + col0 + bj * HALF) = w; }
                asm volatile("" ::: "memory"); }
    }
};
template <int ACT> struct EpiPlain {
    static constexpr bool PERM = true, AFTER_DRAIN = false, HAS_MID = false;
    bf16_t* O; int ldc;
    __device__ __forceinline__ void mid(f32x4 (&)[2][2][4][2], const Unit&, int, int, int, int, int) const {}
    __device__ __forceinline__ void operator()(const f32x4 (&acc)[2][2][4][2], const Unit& u, int wr, int wc, int fr, int fq) const {
        const int row0 = u.pm * BM + wr * 64 + fr, col0 = u.pn * BM + wc * 32 + 8 * fq;
#pragma unroll
        for (int ai = 0; ai < 2; ++ai)
#pragma unroll
            for (int m = 0; m < 4; ++m) { bf16_t* rowp = O + (size_t)(row0 + ai * HALF + m * 16) * ldc + col0;
#pragma unroll
                for (int bj = 0; bj < 2; ++bj) { f32x4 v0 = acc[ai][bj][m][0], v1 = acc[ai][bj][m][1];
                    if (ACT == 1) {
#pragma unroll
                        for (int j = 0; j < 4; ++j) { const float a = v0[j] > 0.f ? v0[j] : 0.f, b = v1[j] > 0.f ? v1[j] : 0.f; v0[j] = a * a; v1[j] = b * b; } }
                    u32x4 w; w.x = cvt_pk_bf16(v0[0], v0[1]); w.y = cvt_pk_bf16(v0[2], v0[3]); w.z = cvt_pk_bf16(v1[0], v1[1]); w.w = cvt_pk_bf16(v1[2], v1[3]);
                    *(u32x4*)(rowp + bj * HALF) = w; } }
    }
};

template <class Epi, class Sched, bool ALIGN_EPI = false, bool SP2 = false>
__device__ __forceinline__ void gemm_phase(PG8_LAS unsigned char* lds, const Gemm g, const Sched& S, const Epi& E) {
    int tid_ = threadIdx.x; asm volatile("" : "+v"(tid_));
    const int tid = tid_, wid = __builtin_amdgcn_readfirstlane(tid >> 6), lane = tid & 63, wr = wid >> 2, wc = wid & 3, fr = lane & 15, fq = lane >> 4;
    const int K = g.K, nt = K / BK;
    unsigned voffA[2], voffB[2];
#pragma unroll
    for (int i = 0; i < 2; ++i) { int R, C; stage_rc(tid * 16 + i * 8192, R, C); const int Rb = Epi::PERM ? ((R & ~31) + perm32(R & 31)) : R;
        voffA[i] = (unsigned)(R * K + C) * 2u; voffB[i] = (unsigned)(Rb * K + C) * 2u; }
    const size_t kstep = (size_t)(BK * 2);
    const size_t hstep = (size_t)HALF * K * 2;
    const size_t tstep = 2 * hstep;
    const unsigned ldsw = (unsigned)wid * 1024u;
    const int aoff = lds_byte(wr * 64 + fr, fq * 8), boff = lds_byte(wc * 32 + fr, fq * 8);
#define PG8_SA(b, h) (((b) * 2 + (h)) * HTB)
#define PG8_SB(b, h) ((4 + (b) * 2 + (h)) * HTB)
#define PG8_STAGE(bufoff, gbase, voff) do { _Pragma("unroll") for (int _i = 0; _i < 2; ++_i) \
        __builtin_amdgcn_global_load_lds((const unsigned*)((const char*)(gbase) + (voff)[_i]), (PG8_LAS unsigned*)(lds + (bufoff) + ldsw + _i * 8192), 16, 0, 0); } while (0)
#define PG8_LDA(dst, b, h) do { _Pragma("unroll") for (int m = 0; m < 4; ++m) _Pragma("unroll") for (int k = 0; k < 2; ++k) dst[m][k] = *(const PG8_LAS bf16x8*)(lds + PG8_SA(b, h) + aoff + m * 2048 + k * 1024); } while (0)
#define PG8_LDB(dst, b, h) do { _Pragma("unroll") for (int n = 0; n < 2; ++n) _Pragma("unroll") for (int k = 0; k < 2; ++k) dst[n][k] = *(const PG8_LAS bf16x8*)(lds + PG8_SB(b, h) + boff + n * 2048 + k * 1024); } while (0)
#define PG8_MMA(ai, bj, At, Bt) do { __builtin_amdgcn_s_setprio(1); _Pragma("unroll") for (int m = 0; m < 4; ++m) _Pragma("unroll") for (int n = 0; n < 2; ++n) _Pragma("unroll") for (int k = 0; k < 2; ++k) \
        acc[ai][bj][m][n] = __builtin_amdgcn_mfma_f32_16x16x32_bf16(Bt[n][k], At[m][k], acc[ai][bj][m][n], 0, 0, 0); __builtin_amdgcn_s_setprio(0); } while (0)
#define PG8_WAIT_V(n) asm volatile("s_waitcnt vmcnt(" #n ")" ::: "memory")
#define PG8_WAIT_L(n) asm volatile("s_waitcnt lgkmcnt(" #n ")" ::: "memory")
#define PG8_BAR __builtin_amdgcn_s_barrier()
#define PG8_SCHED __builtin_amdgcn_sched_barrier(0)
    Unit cur, nxt; int ui = 0;
    if (!S.next(0, cur)) return;
    f32x4 acc[2][2][4][2];
#pragma unroll
    for (int a = 0; a < 2; ++a)
#pragma unroll
        for (int b = 0; b < 2; ++b)
#pragma unroll
            for (int m = 0; m < 4; ++m)
#pragma unroll
                for (int n = 0; n < 2; ++n) acc[a][b][m][n] = (f32x4){0.f, 0.f, 0.f, 0.f};
    bf16x8 At[4][2], B0[2][2], B1[2][2];
    const char* cA = (const char*)g.A + (size_t)cur.pm * tstep; const char* cB = (const char*)g.Bt + (size_t)cur.pn * tstep;
    S.a_ready(cur);
    if constexpr (SP2) {
        PG8_STAGE(PG8_SB(0, 0), cB, voffB); PG8_STAGE(PG8_SB(0, 1), cB + hstep, voffB); PG8_STAGE(PG8_SA(0, 0), cA, voffA); PG8_STAGE(PG8_SA(0, 1), cA + hstep, voffA);
        if (wr == 1) PG8_BAR;
        PG8_WAIT_V(2); PG8_BAR;
        PG8_STAGE(PG8_SB(1, 0), cB + kstep, voffB); PG8_STAGE(PG8_SA(1, 0), cA + kstep, voffA); PG8_STAGE(PG8_SB(1, 1), cB + hstep + kstep, voffB);
        PG8_WAIT_V(6); PG8_BAR;
    } else {
        PG8_STAGE(PG8_SB(0, 0), cB, voffB); PG8_STAGE(PG8_SA(0, 0), cA, voffA); PG8_STAGE(PG8_SB(0, 1), cB + hstep, voffB); PG8_STAGE(PG8_SA(0, 1), cA + hstep, voffA);
        if (wr == 1) PG8_BAR;
        PG8_WAIT_V(4); PG8_BAR;
        PG8_STAGE(PG8_SB(1, 0), cB + kstep, voffB); PG8_STAGE(PG8_SA(1, 0), cA + kstep, voffA); PG8_STAGE(PG8_SB(1, 1), cB + hstep + kstep, voffB);
        PG8_WAIT_V(6); PG8_BAR;
    }
    for (;;) {
        const bool has_next = S.next(ui + 1, nxt);
        const char* nA = has_next ? (const char*)g.A + (size_t)nxt.pm * tstep : cA; const char* nB = has_next ? (const char*)g.Bt + (size_t)nxt.pn * tstep : cB;
        for (int t = 0; t < nt; t += 2) {
            const bool last = (t == nt - 2);
            const char* a1 = cA + (size_t)(t + 1) * kstep;
            const char* a2 = last ? nA : cA + (size_t)(t + 2) * kstep; const char* b2 = last ? nB : cB + (size_t)(t + 2) * kstep;
            const char* a3 = a2 + kstep; const char* b3 = b2 + kstep;
            if (last && has_next) S.a_ready(nxt);
            if constexpr (SP2) {
            PG8_LDB(B0, 0, 0); PG8_LDB(B1, 0, 1); PG8_SCHED; PG8_LDA(At, 0, 0); PG8_STAGE(PG8_SA(1, 1), a1 + hstep, voffA);
            PG8_WAIT_V(8); PG8_WAIT_L(0); PG8_BAR; PG8_MMA(0, 0, At, B0); PG8_MMA(0, 1, At, B1); PG8_BAR; PG8_SCHED;
            PG8_LDA(At, 0, 1); PG8_STAGE(PG8_SB(0, 0), b2, voffB); PG8_STAGE(PG8_SB(0, 1), b2 + hstep, voffB); PG8_STAGE(PG8_SA(0, 0), a2, voffA);
            PG8_WAIT_V(8); PG8_WAIT_L(0); PG8_BAR; PG8_MMA(1, 0, At, B0); PG8_MMA(1, 1, At, B1); PG8_BAR; PG8_SCHED;
            PG8_LDB(B0, 1, 0); PG8_LDB(B1, 1, 1); PG8_SCHED; PG8_LDA(At, 1, 0); PG8_STAGE(PG8_SA(0, 1), a2 + hstep, voffA);
            PG8_WAIT_V(8); PG8_WAIT_L(0); PG8_BAR; PG8_MMA(0, 0, At, B0); PG8_MMA(0, 1, At, B1); PG8_BAR; PG8_SCHED;
            PG8_LDA(At, 1, 1); PG8_STAGE(PG8_SB(1, 0), b3, voffB); PG8_STAGE(PG8_SB(1, 1), b3 + hstep, voffB); PG8_STAGE(PG8_SA(1, 0), a3, voffA);
            PG8_WAIT_V(8); PG8_WAIT_L(0); PG8_BAR; PG8_MMA(1, 0, At, B0); PG8_MMA(1, 1, At, B1); PG8_BAR; PG8_SCHED;
            } else {
            PG8_LDB(B0, 0, 0); PG8_SCHED; PG8_LDA(At, 0, 0); PG8_STAGE(PG8_SA(1, 1), a1 + hstep, voffA);
            PG8_WAIT_L(8); PG8_BAR; PG8_WAIT_L(0); PG8_MMA(0, 0, At, B0); PG8_BAR; PG8_SCHED;
            PG8_LDB(B1, 0, 1); PG8_STAGE(PG8_SB(0, 0), b2, voffB);
            PG8_BAR; PG8_WAIT_L(0); PG8_MMA(0, 1, At, B1); PG8_BAR;
            PG8_LDA(At, 0, 1); PG8_STAGE(PG8_SA(0, 0), a2, voffA);
            PG8_BAR; PG8_WAIT_L(0); PG8_MMA(1, 0, At, B0); PG8_BAR; PG8_SCHED;
            PG8_STAGE(PG8_SB(0, 1), b2 + hstep, voffB);
            PG8_WAIT_V(6); PG8_BAR; PG8_MMA(1, 1, At, B1); PG8_BAR;
            PG8_LDB(B0, 1, 0); PG8_SCHED; PG8_LDA(At, 1, 0); PG8_STAGE(PG8_SA(0, 1), a2 + hstep, voffA);
            PG8_WAIT_L(8); PG8_BAR; PG8_WAIT_L(0); PG8_MMA(0, 0, At, B0); PG8_BAR; PG8_SCHED;
            PG8_LDB(B1, 1, 1); PG8_STAGE(PG8_SB(1, 0), b3, voffB);
            PG8_BAR; PG8_WAIT_L(0); PG8_MMA(0, 1, At, B1); PG8_BAR;
            PG8_LDA(At, 1, 1); PG8_STAGE(PG8_SA(1, 0), a3, voffA);
            PG8_BAR; PG8_WAIT_L(0); PG8_MMA(1, 0, At, B0); PG8_BAR; PG8_SCHED;
            PG8_STAGE(PG8_SB(1, 1), b3 + hstep, voffB);
            PG8_WAIT_V(6); PG8_BAR; PG8_MMA(1, 1, At, B1); PG8_BAR;
            }
            if constexpr (Epi::HAS_MID) { if (t + 2 < nt && ((t + 2) & 7) == 0) E.mid(acc, cur, (t + 2) >> 3, wr, wc, fr, fq); }
        }
        if constexpr (ALIGN_EPI) { if (wr == 0) PG8_BAR; }
        if constexpr (!Epi::AFTER_DRAIN) { E(acc, cur, wr, wc, fr, fq); S.done(cur); }
        if (!has_next) break;
#pragma unroll
        for (int a = 0; a < 2; ++a)
#pragma unroll
            for (int b = 0; b < 2; ++b)
#pragma unroll
                for (int m = 0; m < 4; ++m)
#pragma unroll
                    for (int n = 0; n < 2; ++n) acc[a][b][m][n] = (f32x4){0.f, 0.f, 0.f, 0.f};
        cur = nxt; cA = nA; cB = nB; ++ui;
        if constexpr (ALIGN_EPI) { if (wr == 1) PG8_BAR; }
    }
    PG8_WAIT_V(0);
    if constexpr (!ALIGN_EPI) { if (wr == 0) PG8_BAR; }
    PG8_BAR;
    if constexpr (Epi::AFTER_DRAIN) { E.fused(acc, cur, wr, wc, fr, fq, lds, wid, lane); S.done(cur); }
#undef PG8_SA
#undef PG8_SB
#undef PG8_STAGE
#undef PG8_LDA
#undef PG8_LDB
#undef PG8_MMA
#undef PG8_WAIT_V
#undef PG8_WAIT_L
#undef PG8_BAR
#undef PG8_SCHED
}
}
#ifndef PG8_SP2
#define PG8_SP2 true
#endif
#ifndef PG8_ALIGN
#define PG8_ALIGN true
#endif
#ifndef MK_ONE_LAUNCH
#define MK_ONE_LAUNCH 1
#endif

constexpr int BATCH = 2, SEQ = 16384, D = 1024, DEPTH = 2, HD = 64, NH = 8, FF = 4096;
constexpr int M = BATCH * SEQ;
constexpr int NIN = 6656;
constexpr int KMRG = 1536;
constexpr float RMS_EPS = 1e-6f;
constexpr int NWAVES = 8;

constexpr size_t MiB = 1u << 20;
constexpr size_t WS_CTL = 0, CTL_ZERO_BYTES = 1 * MiB;
constexpr size_t WS_WIN = 1 * MiB, WS_WBR = 14 * MiB, WS_WO = 17 * MiB, WS_W1 = 19 * MiB, WS_W2 = 27 * MiB;
constexpr size_t WS_X1 = 35 * MiB;
constexpr size_t WS_X2 = 131 * MiB;
constexpr size_t WS_G = 259 * MiB;
constexpr size_t WS_HB = 355 * MiB;
constexpr size_t WS_UC = 419 * MiB;
constexpr size_t WS_KBAR = 503 * MiB;
constexpr size_t WS_END = 504 * MiB;
constexpr size_t WS_MB = 131 * MiB;
constexpr size_t WS_Y = 195 * MiB;
constexpr size_t WS_H = 35 * MiB;
constexpr size_t WS_Y2 = 291 * MiB;
constexpr int CW_BAR = 4096;
constexpr int CW_KMAX = 8192;

constexpr int RING_OFF = 0, RING_BYTES = 131072;
constexpr int LDSCTL_OFF = RING_BYTES, MISC_OFF = LDSCTL_OFF + 320;
constexpr int LDS_BYTES = 147456;

#define GAS __attribute__((address_space(1)))
#define LAS __attribute__((address_space(3)))
typedef unsigned short bf16;
typedef unsigned v4u __attribute__((ext_vector_type(4)));
typedef unsigned v2u __attribute__((ext_vector_type(2)));
typedef float f32x4 __attribute__((ext_vector_type(4)));
typedef GAS unsigned gu32;
#define RLX_AGENT __ATOMIC_RELAXED, __HIP_MEMORY_SCOPE_AGENT
#define LDS_WAIT() asm volatile("s_waitcnt lgkmcnt(0)" ::: "memory")
__device__ __forceinline__ unsigned f2bf(float f) { unsigned u = __builtin_bit_cast(unsigned, f); return (u + 0x7fffu + ((u >> 16) & 1u)) >> 16; }
__device__ __forceinline__ unsigned pk2(float lo, float hi) { return f2bf(lo) | (f2bf(hi) << 16); }
__device__ __forceinline__ float bflo(unsigned w) { return __builtin_bit_cast(float, w << 16); }
__device__ __forceinline__ float bfhi(unsigned w) { return __builtin_bit_cast(float, w & 0xffff0000u); }
__device__ __forceinline__ float bf1(bf16 b) { return __builtin_bit_cast(float, ((unsigned)b) << 16); }
__device__ __forceinline__ float wave_sum(float v) {
#pragma unroll
    for (int o = 1; o < 64; o <<= 1) v += __shfl_xor(v, o);
    return v;
}
__device__ __forceinline__ float wave_max(float v) {
#pragma unroll
    for (int o = 1; o < 64; o <<= 1) v = fmaxf(v, __shfl_xor(v, o));
    return v;
}

#define XB_TMO      128
#define XB_XCNT(j)  (256  + 64 * (j))
#define XB_XSUB(j)  (1280 + 64 * (j))
#define XB_XGEN(j)  (2304 + 64 * (j))
#define XB_TOP      3328
#define XB_TOPGEN   3392
#define XCD_BAR_WORDS 3456
#define XB_SPIN_CAP (1u << 18)

__device__ __forceinline__ unsigned xb_ld(unsigned* p)              { return __hip_atomic_load(p, __ATOMIC_RELAXED, __HIP_MEMORY_SCOPE_AGENT); }
__device__ __forceinline__ unsigned xb_add(unsigned* p, unsigned v) { return __hip_atomic_fetch_add(p, v, __ATOMIC_RELAXED, __HIP_MEMORY_SCOPE_AGENT); }
__device__ __forceinline__ unsigned xb_xcc_id() { return (unsigned)__builtin_amdgcn_s_getreg((3 << 11) | 20) & 0xFu; }
#define XB_SPIN(cond, bar) do { unsigned _sp = 0; while (cond) { __builtin_amdgcn_s_sleep(1); \
    if ((++_sp & 255u) == 0u) { if (xb_ld(&(bar)[XB_TMO])) break; if (_sp > XB_SPIN_CAP) { atomicAdd(&(bar)[XB_TMO], 1u); break; } } } } while (0)

struct XcdBarrier {
    unsigned* bar; unsigned x;
    volatile LAS unsigned* st;
};

__device__ __forceinline__ XcdBarrier xcd_barrier_post(unsigned* bar, volatile LAS unsigned* st) {
    XcdBarrier b; b.bar = bar; b.x = xb_xcc_id(); b.st = st;
    if (threadIdx.x == 0) (void)xb_add(&bar[XB_XCNT(b.x)], 1u);
    return b;
}
__device__ __forceinline__ void xcd_barrier_complete(unsigned* bar, unsigned x, unsigned& nloc, unsigned& nx) {
    const unsigned G = gridDim.x * gridDim.y * gridDim.z;
    unsigned sum, cnt, mine, sp = 0u;
    for (;;) {
        sum = 0u; cnt = 0u; mine = 0u;
#pragma unroll
        for (unsigned j = 0; j < 16; ++j) { const unsigned c = xb_ld(&bar[XB_XCNT(j)]); sum += c; cnt += (c > 0u) ? 1u : 0u; mine = (j == x) ? c : mine; }
        if (sum == G) break;
        __builtin_amdgcn_s_sleep(1);
        if ((++sp & 255u) == 0u) { if (xb_ld(&bar[XB_TMO])) break; if (sp > XB_SPIN_CAP) { atomicAdd(&bar[XB_TMO], 1u); break; } }
    }
    nloc = mine > 0u ? mine : 1u; nx = cnt > 0u ? cnt : 1u;
}

__device__ __forceinline__ void xcd_barrier(const XcdBarrier& b) {
    asm volatile("s_waitcnt vmcnt(0)" ::: "memory");
    __syncthreads();
    if (threadIdx.x == 0) {
        unsigned* bar = b.bar;
        __builtin_amdgcn_s_waitcnt(0);
        unsigned nloc = b.st[0], nx = b.st[1];
        if (nloc == 0u) { xcd_barrier_complete(bar, b.x, nloc, nx); b.st[0] = nloc; b.st[1] = nx; }
        const unsigned old = xb_add(&bar[XB_XSUB(b.x)], 1u);
        const unsigned gen = old / nloc;
        if (old + 1u == (gen + 1u) * nloc) {
            __builtin_amdgcn_fence(__ATOMIC_RELEASE, "agent");
            asm volatile("s_waitcnt vmcnt(0)" ::: "memory");
            const unsigned og = xb_add(&bar[XB_TOP], 1u);
            const unsigned tg = og / nx;
            if (og + 1u == (tg + 1u) * nx) xb_add(&bar[XB_TOPGEN], 1u);
            else XB_SPIN(xb_ld(&bar[XB_TOPGEN]) == tg, bar);
            __builtin_amdgcn_fence(__ATOMIC_ACQUIRE, "agent");
            xb_add(&bar[XB_XGEN(b.x)], 1u);
            asm volatile("s_waitcnt vmcnt(0)" ::: "memory");
        } else {
            XB_SPIN(xb_ld(&bar[XB_XGEN(b.x)]) == gen, bar);
            __builtin_amdgcn_fence(__ATOMIC_ACQUIRE, "agent");
            asm volatile("s_waitcnt vmcnt(0)" ::: "memory");
        }
    }
    __syncthreads();
}

__device__ __forceinline__ void tr_item(const float* W, int ldw, int k0, int n0src, bf16* WT, int ldt, int rowdst0, int kdst0, LAS float* scr, int lane) {
#pragma unroll 8
    for (int i = 0; i < 32; ++i) { const int kk = 2 * i + (lane >> 5); scr[kk * 33 + (lane & 31)] = W[(size_t)(k0 + kk) * ldw + n0src + (lane & 31)]; }
    LDS_WAIT(); asm volatile("" ::: "memory");
    const int c = lane & 7;
#pragma unroll
    for (int j = 0; j < 4; ++j) { const int n = (lane >> 3) + 8 * j; const LAS float* s = scr + (8 * c) * 33 + n;
        v4u o; o.x = pk2(s[0 * 33], s[1 * 33]); o.y = pk2(s[2 * 33], s[3 * 33]); o.z = pk2(s[4 * 33], s[5 * 33]); o.w = pk2(s[6 * 33], s[7 * 33]);
        *(GAS v4u*)(WT + (size_t)(rowdst0 + n) * ldt + kdst0 + k0 + 8 * c) = o; }
    LDS_WAIT(); asm volatile("" ::: "memory");
}
__device__ __forceinline__ void convert_layer(const float* const* in, unsigned char* ws, int l, LAS unsigned char* lds, int wave, int lane, int gw, int NGW, int gtid, int NTH) {
    const float* Win = in[1] + (size_t)l * D * NIN; const float* Wa = in[2] + (size_t)l * 512 * D; const float* Wb = in[3] + (size_t)l * 512 * D; const float* Wc = in[4] + (size_t)l * 512 * D;
    const float* Wo = in[5] + (size_t)l * D * D; const float* Wp = in[6] + (size_t)l * 4 * 128 * 128; const float* Ps = in[7] + (size_t)l * 512;
    const float* W1 = in[12] + (size_t)l * D * FF; const float* W2 = in[13] + (size_t)l * FF * D;
    bf16* WinT = (bf16*)(ws + WS_WIN); bf16* WbrT = (bf16*)(ws + WS_WBR); bf16* WoT = (bf16*)(ws + WS_WO); bf16* W1T = (bf16*)(ws + WS_W1); bf16* W2T = (bf16*)(ws + WS_W2);
    LAS float* scr = (LAS float*)(lds + RING_OFF + wave * 16384);
    constexpr int I_IN = 16 * 208, I_BR = 8 * 32, I_O = 16 * 32, I_1 = 16 * 128, I_2 = 64 * 32, NIT = I_IN + 2 * I_BR + I_O + I_1 + I_2;
    for (int it = gw; it < NIT; it += NGW) {
        int r = it;
        if (r < I_IN) { const int kb = r / 208, nb = r % 208, n0 = 32 * nb, db = n0 >> 9;
            const int sb = db == 1 ? 3 : db == 2 ? 6 : db == 3 ? 1 : db == 4 ? 2 : db == 5 ? 4 : db == 6 ? 5 : db;
            tr_item(Win, NIN, 64 * kb, sb * 512 + (n0 & 511), WinT, D, n0, 0, scr, lane); continue; } r -= I_IN;
        if (r < I_BR) { tr_item(Wa, D, 64 * (r / 32), 32 * (r % 32), WbrT, KMRG, 32 * (r % 32), 0, scr, lane); continue; } r -= I_BR;
        if (r < I_BR) { tr_item(Wb, D, 64 * (r / 32), 32 * (r % 32), WbrT, KMRG, 32 * (r % 32), 512, scr, lane); continue; } r -= I_BR;
        if (r < I_O) { tr_item(Wo, D, 64 * (r / 32), 32 * (r % 32), WoT, D, 32 * (r % 32), 0, scr, lane); continue; } r -= I_O;
        if (r < I_1) { tr_item(W1, FF, 64 * (r / 128), 32 * (r % 128), W1T, D, 32 * (r % 128), 0, scr, lane); continue; } r -= I_1;
        tr_item(W2, D, 64 * (r / 32), 32 * (r % 32), W2T, FF, 32 * (r % 32), 0, scr, lane);
    }
    for (int i = gtid; i < 65536; i += NTH) {
        const int n = i & 1023, rest = i >> 10, g = rest >> 4, cc = rest & 15;
        float a[8];
#pragma unroll
        for (int j = 0; j < 8; ++j) a[j] = 0.f;
        const float* wp = Wp + (size_t)(g * 128 + 8 * cc) * 128;
        for (int d = 0; d < 128; ++d) { const float wsv = Wc[(size_t)(g * 128 + d) * D + n] * Ps[g * 128 + d];
#pragma unroll
            for (int j = 0; j < 8; ++j) a[j] += wp[j * 128 + d] * wsv; }
        v4u o; o.x = pk2(a[0], a[1]); o.y = pk2(a[2], a[3]); o.z = pk2(a[4], a[5]); o.w = pk2(a[6], a[7]);
        *(GAS v4u*)(WbrT + (size_t)n * KMRG + 1024 + g * 128 + 8 * cc) = o;
    }
}
__device__ __forceinline__ void row_norm_bf16(const float* xrow, const float* g, bf16* orow, int lane) {
    const GAS f32x4* xr = (const GAS f32x4*)xrow + lane; const GAS f32x4* gr = (const GAS f32x4*)g + lane;
    f32x4 v[4]; float s = 0.f;
#pragma unroll
    for (int j = 0; j < 4; ++j) { v[j] = xr[64 * j]; s += (v[j].x * v[j].x + v[j].y * v[j].y) + (v[j].z * v[j].z + v[j].w * v[j].w); }
    const float r = 1.0f / sqrtf(wave_sum(s) * (1.0f / D) + RMS_EPS);
    GAS v2u* o8 = (GAS v2u*)orow + lane;
#pragma unroll
    for (int j = 0; j < 4; ++j) { const f32x4 gg = gr[64 * j]; v2u w; w.x = pk2(v[j].x * r * gg.x, v[j].y * r * gg.y); w.y = pk2(v[j].z * r * gg.z, v[j].w * r * gg.w); o8[64 * j] = w; }
}
__device__ __forceinline__ void row_post(const bf16* yrow, const float* xin, float* xout, const float* gpost, bf16* hb, const float* gnext, int lane) {
    const GAS v2u* yr = (const GAS v2u*)yrow + lane;
    f32x4 y[4]; float s = 0.f;
#pragma unroll
    for (int j = 0; j < 4; ++j) { const v2u w = yr[64 * j]; y[j] = (f32x4){bflo(w.x), bfhi(w.x), bflo(w.y), bfhi(w.y)}; s += (y[j].x * y[j].x + y[j].y * y[j].y) + (y[j].z * y[j].z + y[j].w * y[j].w); }
    const float r = 1.0f / sqrtf(wave_sum(s) * (1.0f / D) + RMS_EPS);
    f32x4 x1[4]; float s2 = 0.f;
#pragma unroll
    for (int j = 0; j < 4; ++j) { const f32x4 xi = ((const GAS f32x4*)xin)[lane + 64 * j], gp = ((const GAS f32x4*)gpost)[lane + 64 * j];
        x1[j] = xi + y[j] * r * gp; ((GAS f32x4*)xout)[lane + 64 * j] = x1[j];
        s2 += (x1[j].x * x1[j].x + x1[j].y * x1[j].y) + (x1[j].z * x1[j].z + x1[j].w * x1[j].w); }
    if (hb) {
        const float r2 = 1.0f / sqrtf(wave_sum(s2) * (1.0f / D) + RMS_EPS);
        GAS v2u* o8 = (GAS v2u*)hb + lane;
#pragma unroll
        for (int j = 0; j < 4; ++j) { const f32x4 gn = ((const GAS f32x4*)gnext)[lane + 64 * j]; v2u w; w.x = pk2(x1[j].x * r2 * gn.x, x1[j].y * r2 * gn.y); w.y = pk2(x1[j].z * r2 * gn.z, x1[j].w * r2 * gn.w); o8[64 * j] = w; }
    }
}
__device__ __forceinline__ void kstat_job(const bf16* X2, float* kbar, gu32* kmax, int job, int lane) {
    const int mixer = job >> 10, b = (job >> 9) & 1, h = (job >> 6) & 7, j = job & 63;
    const bf16* rows = X2 + (size_t)(b * SEQ + 256 * j) * 2048 + mixer * 1024 + h * 64;
    const int piece = lane & 7, rg = lane >> 3;
    float a[8]; float mx = 0.f;
#pragma unroll
    for (int i = 0; i < 8; ++i) a[i] = 0.f;
    for (int it = 0; it < 32; ++it) {
        const v4u w = *(const GAS v4u*)(rows + (size_t)(it * 8 + rg) * 2048 + piece * 8);
        const float v0 = bflo(w.x), v1 = bfhi(w.x), v2 = bflo(w.y), v3 = bfhi(w.y), v4 = bflo(w.z), v5 = bfhi(w.z), v6 = bflo(w.w), v7 = bfhi(w.w);
        a[0] += v0; a[1] += v1; a[2] += v2; a[3] += v3; a[4] += v4; a[5] += v5; a[6] += v6; a[7] += v7;
        float ss = (v0 * v0 + v1 * v1) + (v2 * v2 + v3 * v3) + (v4 * v4 + v5 * v5) + (v6 * v6 + v7 * v7);
        ss += __shfl_xor(ss, 1); ss += __shfl_xor(ss, 2); ss += __shfl_xor(ss, 4);
        mx = fmaxf(mx, ss);
    }
#pragma unroll
    for (int i = 0; i < 8; ++i) { a[i] += __shfl_xor(a[i], 8); a[i] += __shfl_xor(a[i], 16); a[i] += __shfl_xor(a[i], 32); }
    if (mixer == 0 && lane < 8) {
        float* o = kbar + ((size_t)((b * 8 + h) * 64 + j)) * 64 + piece * 8;
#pragma unroll
        for (int i = 0; i < 8; ++i) o[i] = a[i] * (1.0f / 256.0f);
    }
    mx = wave_max(mx);
    if (lane == 0) __hip_atomic_fetch_max(kmax + mixer * 16 + b * 8 + h, __builtin_bit_cast(unsigned, mx), RLX_AGENT);
}
__device__ __forceinline__ void pool_items(const bf16* UC, bf16* X1, int gtid, int NTH) {
    for (int i = gtid; i < M * 64; i += NTH) {
        const int t = i >> 6, c0 = (i & 63) * 8, g = c0 >> 7, w = 2 << g, tp = t & (SEQ - 1), cnt = (tp + 1) < w ? (tp + 1) : w;
        float s[8], self[8];
#pragma unroll
        for (int j = 0; j < 8; ++j) s[j] = 0.f;
        for (int k = 0; k < cnt; ++k) {
            const v4u v = *(const GAS v4u*)(UC + (size_t)(t - k) * 512 + c0);
            const float f[8] = {bflo(v.x), bfhi(v.x), bflo(v.y), bfhi(v.y), bflo(v.z), bfhi(v.z), bflo(v.w), bfhi(v.w)};
#pragma unroll
            for (int j = 0; j < 8; ++j) { s[j] += f[j]; if (k == 0) self[j] = f[j]; }
        }
        const float inv = 1.0f / (float)cnt;
        v4u o; o.x = pk2(s[0] * inv - self[0], s[1] * inv - self[1]); o.y = pk2(s[2] * inv - self[2], s[3] * inv - self[3]);
        o.z = pk2(s[4] * inv - self[4], s[5] * inv - self[5]); o.w = pk2(s[6] * inv - self[6], s[7] * inv - self[7]);
        *(GAS v4u*)(X1 + (size_t)t * KMRG + 1024 + c0) = o;
    }
}

__device__ __forceinline__ void nv_chunk(const float (&q)[64], const bf16* Kb, const bf16* Vb, int pos0, int pstride, bool valid, int lane, float& m_run, float& l_lane, float& acc) {
    int pos = pos0 + lane * pstride; pos = pos < 0 ? 0 : pos;
    const GAS v4u* kr = (const GAS v4u*)(Kb + (size_t)pos * 2048);
    float s = 0.f;
#pragma unroll
    for (int c = 0; c < 8; ++c) { const v4u w = kr[c];
        s += q[8 * c] * bflo(w.x) + q[8 * c + 1] * bfhi(w.x) + q[8 * c + 2] * bflo(w.y) + q[8 * c + 3] * bfhi(w.y) + q[8 * c + 4] * bflo(w.z) + q[8 * c + 5] * bfhi(w.z) + q[8 * c + 6] * bflo(w.w) + q[8 * c + 7] * bfhi(w.w); }
    s = valid ? s : -1e30f;
    const float cm = wave_max(s), mn = fmaxf(m_run, cm), alpha = __builtin_amdgcn_exp2f(m_run - mn);
    const float p = valid ? __builtin_amdgcn_exp2f(s - mn) : 0.f;
    l_lane = l_lane * alpha + p;
    float a = 0.f;
#pragma unroll 16
    for (int kk = 0; kk < 64; ++kk) {
        const float pk = __builtin_bit_cast(float, __builtin_amdgcn_readlane(__builtin_bit_cast(int, p), kk));
        int pp = pos0 + kk * pstride; pp = pp < 0 ? 0 : pp;
        a += pk * bf1(Vb[(size_t)pp * 2048 + lane]);
    }
    acc = acc * alpha + a; m_run = mn;
}
__device__ __forceinline__ void nv_load_q(float (&q)[64], const bf16* qrow) {
#pragma unroll
    for (int c = 0; c < 8; ++c) { const v4u w = ((const GAS v4u*)qrow)[c];
        q[8 * c] = bflo(w.x); q[8 * c + 1] = bfhi(w.x); q[8 * c + 2] = bflo(w.y); q[8 * c + 3] = bfhi(w.y); q[8 * c + 4] = bflo(w.z); q[8 * c + 5] = bfhi(w.z); q[8 * c + 6] = bflo(w.w); q[8 * c + 7] = bfhi(w.w); }
}
__device__ __forceinline__ void nv_moba(bf16* X1, const bf16* X2, const float* kbar, int b, int t, int h, int lane) {
    bf16* qrow = X1 + (size_t)(b * SEQ + t) * KMRG + h * 64;
    float q[64]; nv_load_q(q, qrow);
    const bf16* Kb = X2 + (size_t)b * SEQ * 2048 + h * 64; const bf16* Vb = Kb + 512;
    const int n = t >> 8;
    float sc = -INFINITY;
    if (lane < n) { const GAS f32x4* kb = (const GAS f32x4*)(kbar + ((size_t)((b * 8 + h) * 64 + lane)) * 64); float s = 0.f;
#pragma unroll
        for (int c = 0; c < 16; ++c) { const f32x4 w = kb[c]; s += q[4 * c] * w.x + q[4 * c + 1] * w.y + q[4 * c + 2] * w.z + q[4 * c + 3] * w.w; }
        sc = s; }
    float m_run = -1e30f, l_lane = 0.f, acc = 0.f;
    for (int r = 0; r < 3; ++r) {
        float bv = sc; int bi = lane;
#pragma unroll
        for (int o = 1; o < 64; o <<= 1) { const float ov = __shfl_xor(bv, o); const int oi = __shfl_xor(bi, o); if (ov > bv || (ov == bv && oi < bi)) { bv = ov; bi = oi; } }
        if (!(bv > -INFINITY)) break;
        bi = __builtin_amdgcn_readfirstlane(bi);
        if (lane == bi) sc = -INFINITY;
        for (int c = 0; c < 4; ++c) nv_chunk(q, Kb, Vb, bi * 256 + 64 * c, 1, true, lane, m_run, l_lane, acc);
    }
    const int nc = ((t & 255) >> 6) + 1;
    for (int c = 0; c < nc; ++c) { const int pos0 = n * 256 + 64 * c; nv_chunk(q, Kb, Vb, pos0, 1, (pos0 + lane) <= t, lane, m_run, l_lane, acc); }
    const float o = acc / wave_sum(l_lane);
    qrow[lane] = (bf16)f2bf(o);
}
__device__ __forceinline__ void nv_dil(bf16* X1, const bf16* X2, int b, int t, int h, int lane) {
    bf16* qrow = X1 + (size_t)(b * SEQ + t) * KMRG + 512 + h * 64;
    float q[64]; nv_load_q(q, qrow);
    const bf16* Kb = X2 + (size_t)b * SEQ * 2048 + 1024 + h * 64; const bf16* Vb = Kb + 512;
    float m_run = -1e30f, l_lane = 0.f, acc = 0.f;
#pragma unroll
    for (int p = 0; p < 3; ++p) { const int d = p == 0 ? 1 : (p == 1 ? 4 : 16);
        for (int c = 0; c < 3; ++c) { const int mm = 64 * c + lane; nv_chunk(q, Kb, Vb, t - 64 * c * d, -d, (mm <= 128) && (t - mm * d >= 0), lane, m_run, l_lane, acc); } }
    const float o = acc / wave_sum(l_lane);
    qrow[lane] = (bf16)f2bf(o);
}

constexpr int PH_PER_LAYER = 9, NPH = 1 + DEPTH * PH_PER_LAYER;
struct Args { const float* in[14]; float* out; unsigned char* ws; int ph_lo, ph_hi; };
__global__ void __launch_bounds__(NWAVES * 64, 2) fwd(Args args) {
    extern __shared__ __attribute__((aligned(16))) unsigned char lds_raw[];
    LAS unsigned char* lds = (LAS unsigned char*)lds_raw;
    const int tid = threadIdx.x;
    const int G = gridDim.x, NGW = G * NWAVES, NTH = G * NWAVES * 64;
#define CTL ((gu32*)(wsb + WS_CTL))
    unsigned char* wsb = args.ws;
    volatile LAS unsigned* MISC = (volatile LAS unsigned*)(lds + MISC_OFF);
    for (int u = tid; u < (LDS_BYTES - LDSCTL_OFF) / 4; u += NWAVES * 64) ((LAS unsigned*)(lds + LDSCTL_OFF))[u] = 0u;
    __syncthreads();
#if MK_ONE_LAUNCH
    XcdBarrier bar = xcd_barrier_post((unsigned*)(CTL + CW_BAR), MISC + 8);
#define SEAM(p) do { if ((p) + 1 < hi) xcd_barrier(bar); } while (0)
#else
#define SEAM(p) do { } while (0)
#endif
    const int lo = args.ph_lo, hi = args.ph_hi;
#define IN(k) (lo <= (k) && (k) < hi)
#define PHB() int tidp = threadIdx.x; asm volatile("" : "+v"(tidp)); const int lane = tidp & 63, wave = __builtin_amdgcn_readfirstlane(tidp >> 6); const int gw = blockIdx.x * NWAVES + wave, gtid = blockIdx.x * (NWAVES * 64) + tidp; unsigned char* wsb = args.ws; asm volatile("" : "+s"(wsb)); (void)lane; (void)wave; (void)gw; (void)gtid;
#define X1 ((bf16*)(wsb + WS_X1))
#define X2 ((bf16*)(wsb + WS_X2))
#define GT (wsb + WS_G)
#define HB ((bf16*)(wsb + WS_HB))
#define UC ((bf16*)(wsb + WS_UC))
#define KBAR ((float*)(wsb + WS_KBAR))
#define MB ((bf16*)(wsb + WS_MB))
#define YB ((bf16*)(wsb + WS_Y))
#define HH ((bf16*)(wsb + WS_H))
#define Y2 ((bf16*)(wsb + WS_Y2))
#define WSP(off) (wsb + (off))

    if (IN(0)) { PHB();
        convert_layer(args.in, wsb, 0, lds, wave, lane, gw, NGW, gtid, NTH);
        for (int m = gw; m < M; m += NGW) row_norm_bf16(args.in[0] + (size_t)m * D, args.in[8], HB + (size_t)m * D, lane);
        SEAM(0);
    }
    for (int l = 0; l < DEPTH; ++l) {
        const int pb = 1 + l * PH_PER_LAYER;
        if (IN(pb + 0)) { PHB();
            pg8::Gemm g{HB, (const bf16*)WSP(WS_WIN), M, NIN, D}; pg8::StaticOrder S; S.init(M, NIN, G, (int)blockIdx.x);
            pg8::EpiIn E{X1, UC, X2, GT};
            pg8::gemm_phase<pg8::EpiIn, pg8::StaticOrder, PG8_ALIGN, PG8_SP2>(lds + RING_OFF, g, S, E);
            SEAM(pb + 0);
        }
        if (IN(pb + 1)) { PHB();
            for (int job = gw; job < 2048; job += NGW) kstat_job(X2, KBAR, CTL + CW_KMAX + l * 32, job, lane);
            pool_items(UC, X1, gtid, NTH);
            SEAM(pb + 1);
        }
        if (IN(pb + 2)) { PHB();
            for (int job = gw; job < M * NH; job += NGW) { const int tg = job >> 3, h = job & 7; nv_moba(X1, X2, KBAR, tg >> 14, tg & (SEQ - 1), h, lane); }
            for (int job = gw; job < M * NH; job += NGW) { const int tg = job >> 3, h = job & 7; nv_dil(X1, X2, tg >> 14, tg & (SEQ - 1), h, lane); }
            SEAM(pb + 2);
        }
        if (IN(pb + 3)) { PHB();
            pg8::Gemm g{X1, (const bf16*)WSP(WS_WBR), M, D, KMRG}; pg8::StaticOrder S; S.init(M, D, G, (int)blockIdx.x);
            pg8::EpiMerge E{GT, MB};
            pg8::gemm_phase<pg8::EpiMerge, pg8::StaticOrder, PG8_ALIGN, PG8_SP2>(lds + RING_OFF, g, S, E);
            SEAM(pb + 3);
        }
        if (IN(pb + 4)) { PHB();
            pg8::Gemm g{MB, (const bf16*)WSP(WS_WO), M, D, D}; pg8::StaticOrder S; S.init(M, D, G, (int)blockIdx.x);
            pg8::EpiPlain<0> E{YB, D};
            pg8::gemm_phase<pg8::EpiPlain<0>, pg8::StaticOrder, PG8_ALIGN, PG8_SP2>(lds + RING_OFF, g, S, E);
            SEAM(pb + 4);
        }
        if (IN(pb + 5)) { PHB();
            const float* xi = l == 0 ? args.in[0] : (const float*)args.out;
            for (int m = gw; m < M; m += NGW) row_post(YB + (size_t)m * D, xi + (size_t)m * D, args.out + (size_t)m * D, args.in[9] + l * D, HB + (size_t)m * D, args.in[10] + l * D, lane);
            SEAM(pb + 5);
        }
        if (IN(pb + 6)) { PHB();
            pg8::Gemm g{HB, (const bf16*)WSP(WS_W1), M, FF, D}; pg8::StaticOrder S; S.init(M, FF, G, (int)blockIdx.x);
            pg8::EpiPlain<1> E{HH, FF};
            pg8::gemm_phase<pg8::EpiPlain<1>, pg8::StaticOrder, PG8_ALIGN, PG8_SP2>(lds + RING_OFF, g, S, E);
            SEAM(pb + 6);
        }
        if (IN(pb + 7)) { PHB();
            pg8::Gemm g{HH, (const bf16*)WSP(WS_W2), M, D, FF}; pg8::StaticOrder S; S.init(M, D, G, (int)blockIdx.x);
            pg8::EpiPlain<0> E{Y2, D};
            pg8::gemm_phase<pg8::EpiPlain<0>, pg8::StaticOrder, PG8_ALIGN, PG8_SP2>(lds + RING_OFF, g, S, E);
            SEAM(pb + 7);
        }
        if (IN(pb + 8)) { PHB();
            const bool more = (l + 1 < DEPTH);
            for (int m = gw; m < M; m += NGW) row_post(Y2 + (size_t)m * D, args.out + (size_t)m * D, args.out + (size_t)m * D, args.in[11] + l * D, more ? HB + (size_t)m * D : (bf16*)nullptr, args.in[8] + (l + 1 < DEPTH ? l + 1 : l) * D, lane);
            if (more) convert_layer(args.in, wsb, l + 1, lds, wave, lane, gw, NGW, gtid, NTH);
            SEAM(pb + 8);
        }
    }
#undef IN
#undef SEAM
}

extern "C" void kernel_launch(void* const* d_in, const int* in_sizes, int n_in, void* d_out, int out_size, void* d_ws, size_t ws_size, hipStream_t stream) {
    static int grid = 0;
    if (grid == 0) {
        if (n_in != 14 || in_sizes[0] != M * D || out_size != M * D || ws_size < WS_END) { fprintf(stderr, "kernel_launch: unexpected shapes / workspace (n_in %d, in0 %d, out %d, ws %zu); nothing launched\n", n_in, n_in > 0 ? in_sizes[0] : -1, out_size, ws_size); grid = -1; return; }
        int dev = 0, cus = 0, per_cu = 0;
        if (hipGetDevice(&dev) != hipSuccess || hipDeviceGetAttribute(&cus, hipDeviceAttributeMultiprocessorCount, dev) != hipSuccess) { grid = -1; return; }
        if (hipFuncSetAttribute((const void*)fwd, hipFuncAttributeMaxDynamicSharedMemorySize, LDS_BYTES) != hipSuccess) { fprintf(stderr, "kernel_launch: hipFuncSetAttribute failed\n"); grid = -1; return; }
        if (hipOccupancyMaxActiveBlocksPerMultiprocessor(&per_cu, (const void*)fwd, NWAVES * 64, LDS_BYTES) != hipSuccess || per_cu < 1) fprintf(stderr, "kernel_launch: occupancy query reports %d workgroups per CU\n", per_cu);
        (void)hipGetLastError();
        grid = cus;
    }
    if (grid < 0) return;
    if (hipMemsetAsync((char*)d_ws + WS_CTL, 0, CTL_ZERO_BYTES, stream) != hipSuccess) return;
    Args a{};
    for (int i = 0; i < 14; ++i) a.in[i] = (const float*)d_in[i];
    a.out = (float*)d_out; a.ws = (unsigned char*)d_ws;
#if MK_ONE_LAUNCH
    a.ph_lo = 0; a.ph_hi = NPH;
    hipLaunchKernelGGL(fwd, dim3(grid), dim3(NWAVES * 64), LDS_BYTES, stream, a);
#else
    for (int p = 0; p < NPH; ++p) { a.ph_lo = p; a.ph_hi = p + 1; hipLaunchKernelGGL(fwd, dim3(grid), dim3(NWAVES * 64), LDS_BYTES, stream, a); }
#endif
}
```

```cpp
#include <hip/hip_runtime.h>
#include <cstdio>
#include <cstdint>
#include <cmath>
namespace pg8 {
#define PG8_LAS __attribute__((address_space(3)))
typedef unsigned short bf16_t;
typedef short bf16x8 __attribute__((ext_vector_type(8)));
typedef float f32x4 __attribute__((ext_vector_type(4)));
typedef unsigned u32x4 __attribute__((ext_vector_type(4)));
constexpr int BM = 256, BK = 64, HALF = 128, HTB = HALF * BK * 2  , STAGE_BYTES = 8 * HTB, NXCD = 8, WGM = 8;

__host__ __device__ __forceinline__ int lds_byte(int r, int c) { const int st = (r >> 4) * 2 + (c >> 5), rr = r & 15, cc = c & 31, ob = rr * 64 + cc * 2; return st * 1024 + (ob ^ (((ob >> 9) & 1) << 5)); }
__host__ __device__ __forceinline__ void stage_rc(int b, int& R, int& C) { const int st = b / 1024, sb = b % 1024, swz = sb ^ (((sb >> 9) & 1) << 5); R = (st >> 1) * 16 + swz / 64; C = (st & 1) * 32 + (swz % 64) / 2; }
__host__ __device__ __forceinline__ int perm32(int rho) { const int n = rho >> 4, i = rho & 15; return 8 * (i >> 2) + 4 * n + (i & 3); }

struct Unit { int pm, pn; };
struct Gemm { const bf16_t* A; const bf16_t* Bt; int M, N, K; };

struct StaticOrder {
    int nM, nN, nwg, G, c;
    __host__ __device__ void init(int M, int N, int G_, int c_) { nM = M / BM; nN = N / BM; nwg = nM * nN; G = G_; c = c_; }
    __host__ __device__ bool next(int i, Unit& u) const {
        const long L = (long)i * G + c; if (L >= nwg) return false;
        int wgid = (int)L; { const int q = nwg / NXCD, r = nwg % NXCD, xcd = wgid % NXCD, off = wgid / NXCD; wgid = (xcd < r ? xcd * (q + 1) : r * (q + 1) + (xcd - r) * q) + off; }
        const int nig = WGM * nN, gid = wgid / nig, fm = gid * WGM, gsz = (nM - fm) < WGM ? (nM - fm) : WGM;
        u.pm = fm + ((wgid % nig) % gsz); u.pn = (wgid % nig) / gsz; return true;
    }
    __device__ __forceinline__ void a_ready(const Unit&) const {}
    __device__ __forceinline__ void done(const Unit&) const {}
};

__device__ __forceinline__ unsigned cvt_pk_bf16(float lo, float hi) { unsigned r; asm volatile("v_cvt_pk_bf16_f32 %0, %1, %2" : "=v"(r) : "v"(lo), "v"(hi)); return r; }
typedef float f32x2 __attribute__((ext_vector_type(2)));
typedef unsigned u32x2 __attribute__((ext_vector_type(2)));
constexpr float kC2 = 0.125f * 1.4426950408889634f;

__device__ __forceinline__ unsigned sig_u8(float z) {
    const float g = __builtin_amdgcn_rcpf(1.0f + __builtin_amdgcn_exp2f(-1.4426950408889634f * z));
    float q = __builtin_rintf(g * 255.0f); q = q < 1.0f ? 1.0f : (q > 255.0f ? 255.0f : q);
    return (unsigned)q;
}
struct EpiIn {
    static constexpr bool PERM = true, AFTER_DRAIN = false, HAS_MID = false;
    bf16_t* X1; bf16_t* UC; bf16_t* X2; unsigned char* G;
    __device__ __forceinline__ void mid(f32x4 (&)[2][2][4][2], const Unit&, int, int, int, int, int) const {}
    __device__ __forceinline__ void operator()(const f32x4 (&acc)[2][2][4][2], const Unit& u, int wr, int wc, int fr, int fq) const {
        const int row0 = u.pm * BM + wr * 64 + fr, pn = u.pn;
        if (pn < 14) {
            bf16_t* base; int ldc, colt; float sc = 1.0f;
            if (pn < 4) { base = X1; ldc = 1536; colt = pn * BM; sc = kC2; }
            else if (pn < 6) { base = UC; ldc = 512; colt = (pn - 4) * BM; }
            else { base = X2; ldc = 2048; colt = (pn - 6) * BM; }
            const int col0 = colt + wc * 32 + 8 * fq;
#pragma unroll
            for (int ai = 0; ai < 2; ++ai)
#pragma unroll
                for (int m = 0; m < 4; ++m) { bf16_t* rowp = base + (size_t)(row0 + ai * HALF + m * 16) * ldc + col0;
#pragma unroll
                    for (int bj = 0; bj < 2; ++bj) { const f32x4 v0 = acc[ai][bj][m][0] * sc, v1 = acc[ai][bj][m][1] * sc;
                        u32x4 w; w.x = cvt_pk_bf16(v0[0], v0[1]); w.y = cvt_pk_bf16(v0[2], v0[3]); w.z = cvt_pk_bf16(v1[0], v1[1]); w.w = cvt_pk_bf16(v1[2], v1[3]);
                        *(u32x4*)(rowp + bj * HALF) = w; } }
        } else {
            const int col0 = (pn - 14) * BM + wc * 32 + 8 * fq;
#pragma unroll
            for (int ai = 0; ai < 2; ++ai)
#pragma unroll
                for (int m = 0; m < 4; ++m) { unsigned char* rowp = G + (size_t)(row0 + ai * HALF + m * 16) * 3072 + col0;
#pragma unroll
                    for (int bj = 0; bj < 2; ++bj) { const f32x4 v0 = acc[ai][bj][m][0], v1 = acc[ai][bj][m][1];
                        u32x2 w; w.x = sig_u8(v0[0]) | (sig_u8(v0[1]) << 8) | (sig_u8(v0[2]) << 16) | (sig_u8(v0[3]) << 24);
                        w.y = sig_u8(v1[0]) | (sig_u8(v1[1]) << 8) | (sig_u8(v1[2]) << 16) | (sig_u8(v1[3]) << 24);
                        *(u32x2*)(rowp + bj * HALF) = w; } }
        }
    }
};
struct EpiMerge {
    static constexpr bool PERM = true, AFTER_DRAIN = false, HAS_MID = true;
    const unsigned char* G; bf16_t* O;
    __device__ __forceinline__ void mid(f32x4 (&acc)[2][2][4][2], const Unit& u, int seg, int wr, int wc, int fr, int fq) const {
        int row0 = u.pm * BM + wr * 64 + fr, col0 = u.pn * BM + wc * 32 + 8 * fq;
        asm volatile("" : "+v"(row0), "+v"(col0));
#pragma unroll
        for (int ai = 0; ai < 2; ++ai)
#pragma unroll
            for (int m = 0; m < 4; ++m) { const unsigned char* rowp = G + (size_t)(row0 + ai * HALF + m * 16) * 3072 + col0;
#pragma unroll
                for (int bj = 0; bj < 2; ++bj) {
                    const u32x2 ga = *(const u32x2*)(rowp + (seg - 1) * 1024 + bj * HALF), gb = *(const u32x2*)(rowp + seg * 1024 + bj * HALF);
                    f32x4 r0, r1;
#pragma unroll
                    for (int j = 0; j < 4; ++j) { r0[j] = (float)((ga.x >> (8 * j)) & 255u) * __builtin_amdgcn_rcpf((float)((gb.x >> (8 * j)) & 255u));
                                                  r1[j] = (float)((ga.y >> (8 * j)) & 255u) * __builtin_amdgcn_rcpf((float)((gb.y >> (8 * j)) & 255u)); }
                    acc[ai][bj][m][0] *= r0; acc[ai][bj][m][1] *= r1; }
                asm volatile("" ::: "memory"); }
    }
    __device__ __forceinline__ void operator()(const f32x4 (&acc)[2][2][4][2], const Unit& u, int wr, int wc, int fr, int fq) const {
        const int row0 = u.pm * BM + wr * 64 + fr, col0 = u.pn * BM + wc * 32 + 8 * fq;
#pragma unroll
        for (int ai = 0; ai < 2; ++ai)
#pragma unroll
            for (int m = 0; m < 4; ++m) { const size_t r = (size_t)(row0 + ai * HALF + m * 16);
#pragma unroll
                for (int bj = 0; bj < 2; ++bj) {
                    const u32x2 gc = *(const u32x2*)(G + r * 3072 + 2048 + col0 + bj * HALF);
                    f32x4 v0 = acc[ai][bj][m][0], v1 = acc[ai][bj][m][1];
#pragma unroll
                    for (int j = 0; j < 4; ++j) { v0[j] *= (float)((gc.x >> (8 * j)) & 255u) * (1.0f / 255.0f); v1[j] *= (float)((gc.y >> (8 * j)) & 255u) * (1.0f / 255.0f); }
                    u32x4 w; w.x = cvt_pk_bf16(v0[0], v0[1]); w.y = cvt_pk_bf16(v0[2], v0[3]); w.z = cvt_pk_bf16(v1[0], v1[1]); w.w = cvt_pk_bf16(v1[2], v1[3]);
                    *(u32x4*)(O + r * 1024 + col0 + bj * HALF) = w; }
                asm volatile("" ::: "memory"); }
    }
};
template <int ACT> struct EpiPlain {
    static constexpr bool PERM = true, AFTER_DRAIN = false, HAS_MID = false;
    bf16_t* O; int ldc;
    __device__ __forceinline__ void mid(f32x4 (&)[2][2][4][2], const Unit&, int, int, int, int, int) const {}
    __device__ __forceinline__ void operator()(const f32x4 (&acc)[2][2][4][2], const Unit& u, int wr, int wc, int fr, int fq) const {
        const int row0 = u.pm * BM + wr * 64 + fr, col0 = u.pn * BM + wc * 32 + 8 * fq;
#pragma unroll
        for (int ai = 0; ai < 2; ++ai)
#pragma unroll
            for (int m = 0; m < 4; ++m) { bf16_t* rowp = O + (size_t)(row0 + ai * HALF + m * 16) * ldc + col0;
#pragma unroll
                for (int bj = 0; bj < 2; ++bj) { f32x4 v0 = acc[ai][bj][m][0], v1 = acc[ai][bj][m][1];
                    if (ACT == 1) {
#pragma unroll
                        for (int j = 0; j < 4; ++j) { const float a = v0[j] > 0.f ? v0[j] : 0.f, b = v1[j] > 0.f ? v1[j] : 0.f; v0[j] = a * a; v1[j] = b * b; } }
                    u32x4 w; w.x = cvt_pk_bf16(v0[0], v0[1]); w.y = cvt_pk_bf16(v0[2], v0[3]); w.z = cvt_pk_bf16(v1[0], v1[1]); w.w = cvt_pk_bf16(v1[2], v1[3]);
                    *(u32x4*)(rowp + bj * HALF) = w; } }
    }
};

template <class Epi, class Sched, bool ALIGN_EPI = false, bool SP2 = false>
__device__ __forceinline__ void gemm_phase(PG8_LAS unsigned char* lds, const Gemm g, const Sched& S, const Epi& E) {
    int tid_ = threadIdx.x; asm volatile("" : "+v"(tid_));
    const int tid = tid_, wid = __builtin_amdgcn_readfirstlane(tid >> 6), lane = tid & 63, wr = wid >> 2, wc = wid & 3, fr = lane & 15, fq = lane >> 4;
    const int K = g.K, nt = K / BK;
    unsigned voffA[2], voffB[2];
#pragma unroll
    for (int i = 0; i < 2; ++i) { int R, C; stage_rc(tid * 16 + i * 8192, R, C); const int Rb = Epi::PERM ? ((R & ~31) + perm32(R & 31)) : R;
        voffA[i] = (unsigned)(R * K + C) * 2u; voffB[i] = (unsigned)(Rb * K + C) * 2u; }
    const size_t kstep = (size_t)(BK * 2);
    const size_t hstep = (size_t)HALF * K * 2;
    const size_t tstep = 2 * hstep;
    const unsigned ldsw = (unsigned)wid * 1024u;
    const int aoff = lds_byte(wr * 64 + fr, fq * 8), boff = lds_byte(wc * 32 + fr, fq * 8);
#define PG8_SA(b, h) (((b) * 2 + (h)) * HTB)
#define PG8_SB(b, h) ((4 + (b) * 2 + (h)) * HTB)
#define PG8_STAGE(bufoff, gbase, voff) do { _Pragma("unroll") for (int _i = 0; _i < 2; ++_i) \
        __builtin_amdgcn_global_load_lds((const unsigned*)((const char*)(gbase) + (voff)[_i]), (PG8_LAS unsigned*)(lds + (bufoff) + ldsw + _i * 8192), 16, 0, 0); } while (0)
#define PG8_LDA(dst, b, h) do { _Pragma("unroll") for (int m = 0; m < 4; ++m) _Pragma("unroll") for (int k = 0; k < 2; ++k) dst[m][k] = *(const PG8_LAS bf16x8*)(lds + PG8_SA(b, h) + aoff + m * 2048 + k * 1024); } while (0)
#define PG8_LDB(dst, b, h) do { _Pragma("unroll") for (int n = 0; n < 2; ++n) _Pragma("unroll") for (int k = 0; k < 2; ++k) dst[n][k] = *(const PG8_LAS bf16x8*)(lds + PG8_SB(b, h) + boff + n * 2048 + k * 1024); } while (0)
#define PG8_MMA(ai, bj, At, Bt) do { __builtin_amdgcn_s_setprio(1); _Pragma("unroll") for (int m = 0; m < 4; ++m) _Pragma("unroll") for (int n = 0; n < 2; ++n) _Pragma("unroll") for (int k = 0; k < 2; ++k) \
        acc[ai][bj][m][n] = __builtin_amdgcn_mfma_f32_16x16x32_bf16(Bt[n][k], At[m][k], acc[ai][bj][m][n], 0, 0, 0); __builtin_amdgcn_s_setprio(0); } while (0)
#define PG8_WAIT_V(n) asm volatile("s_waitcnt vmcnt(" #n ")" ::: "memory")
#define PG8_WAIT_L(n) asm volatile("s_waitcnt lgkmcnt(" #n ")" ::: "memory")
#define PG8_BAR __builtin_amdgcn_s_barrier()
#define PG8_SCHED __builtin_amdgcn_sched_barrier(0)
    Unit cur, nxt; int ui = 0;
    if (!S.next(0, cur)) return;
    f32x4 acc[2][2][4][2];
#pragma unroll
    for (int a = 0; a < 2; ++a)
#pragma unroll
        for (int b = 0; b < 2; ++b)
#pragma unroll
            for (int m = 0; m < 4; ++m)
#pragma unroll
                for (int n = 0; n < 2; ++n) acc[a][b][m][n] = (f32x4){0.f, 0.f, 0.f, 0.f};
    bf16x8 At[4][2], B0[2][2], B1[2][2];
    const char* cA = (const char*)g.A + (size_t)cur.pm * tstep; const char* cB = (const char*)g.Bt + (size_t)cur.pn * tstep;
    S.a_ready(cur);
    if constexpr (SP2) {
        PG8_STAGE(PG8_SB(0, 0), cB, voffB); PG8_STAGE(PG8_SB(0, 1), cB + hstep, voffB); PG8_STAGE(PG8_SA(0, 0), cA, voffA); PG8_STAGE(PG8_SA(0, 1), cA + hstep, voffA);
        if (wr == 1) PG8_BAR;
        PG8_WAIT_V(2); PG8_BAR;
        PG8_STAGE(PG8_SB(1, 0), cB + kstep, voffB); PG8_STAGE(PG8_SA(1, 0), cA + kstep, voffA); PG8_STAGE(PG8_SB(1, 1), cB + hstep + kstep, voffB);
        PG8_WAIT_V(6); PG8_BAR;
    } else {
        PG8_STAGE(PG8_SB(0, 0), cB, voffB); PG8_STAGE(PG8_SA(0, 0), cA, voffA); PG8_STAGE(PG8_SB(0, 1), cB + hstep, voffB); PG8_STAGE(PG8_SA(0, 1), cA + hstep, voffA);
        if (wr == 1) PG8_BAR;
        PG8_WAIT_V(4); PG8_BAR;
        PG8_STAGE(PG8_SB(1, 0), cB + kstep, voffB); PG8_STAGE(PG8_SA(1, 0), cA + kstep, voffA); PG8_STAGE(PG8_SB(1, 1), cB + hstep + kstep, voffB);
        PG8_WAIT_V(6); PG8_BAR;
    }
    for (;;) {
        const bool has_next = S.next(ui + 1, nxt);
        const char* nA = has_next ? (const char*)g.A + (size_t)nxt.pm * tstep : cA; const char* nB = has_next ? (const char*)g.Bt + (size_t)nxt.pn * tstep : cB;
        for (int t = 0; t < nt; t += 2) {
            const bool last = (t == nt - 2);
            const char* a1 = cA + (size_t)(t + 1) * kstep;
            const char* a2 = last ? nA : cA + (size_t)(t + 2) * kstep; const char* b2 = last ? nB : cB + (size_t)(t + 2) * kstep;
            const char* a3 = a2 + kstep; const char* b3 = b2 + kstep;
            if (last && has_next) S.a_ready(nxt);
            if constexpr (SP2) {
            PG8_LDB(B0, 0, 0); PG8_LDB(B1, 0, 1); PG8_SCHED; PG8_LDA(At, 0, 0); PG8_STAGE(PG8_SA(1, 1), a1 + hstep, voffA);
            PG8_WAIT_V(8); PG8_WAIT_L(0); PG8_BAR; PG8_MMA(0, 0, At, B0); PG8_MMA(0, 1, At, B1); PG8_BAR; PG8_SCHED;
            PG8_LDA(At, 0, 1); PG8_STAGE(PG8_SB(0, 0), b2, voffB); PG8_STAGE(PG8_SB(0, 1), b2 + hstep, voffB); PG8_STAGE(PG8_SA(0, 0), a2, voffA);
            PG8_WAIT_V(8); PG8_WAIT_L(0); PG8_BAR; PG8_MMA(1, 0, At, B0); PG8_MMA(1, 1, At, B1); PG8_BAR; PG8_SCHED;
            PG8_LDB(B0, 1, 0); PG8_LDB(B1, 1, 1); PG8_SCHED; PG8_LDA(At, 1, 0); PG8_STAGE(PG8_SA(0, 1), a2 + hstep, voffA);
            PG8_WAIT_V(8); PG8_WAIT_L(0); PG8_BAR; PG8_MMA(0, 0, At, B0); PG8_MMA(0, 1, At, B1); PG8_BAR; PG8_SCHED;
            PG8_LDA(At, 1, 1); PG8_STAGE(PG8_SB(1, 0), b3, voffB); PG8_STAGE(PG8_SB(1, 1), b3 + hstep, voffB); PG8_STAGE(PG8_SA(1, 0), a3, voffA);
            PG8_WAIT_V(8); PG8_WAIT_L(0); PG8_BAR; PG8_MMA(1, 0, At, B0); PG8_MMA(1, 1, At, B1); PG8_BAR; PG8_SCHED;
            } else {
            PG8_LDB(B0, 0, 0); PG8_SCHED; PG8_LDA(At, 0, 0); PG8_STAGE(PG8_SA(1, 1), a1 + hstep, voffA);
            PG8_WAIT_L(8); PG8_BAR; PG8_WAIT_L(0); PG8_MMA(0, 0, At, B0); PG8_BAR; PG8_SCHED;
            PG8_LDB(B1, 0, 1); PG8_STAGE(PG8_SB(0, 0), b2, voffB);
            PG8_BAR; PG8_WAIT_L(0); PG8_MMA(0, 1, At, B1); PG8_BAR;
            PG8_LDA(At, 0, 1); PG8_STAGE(PG8_SA(0, 0), a2, voffA);
            PG8_BAR; PG8_WAIT_L(0); PG8_MMA(1, 0, At, B0); PG8_BAR; PG8_SCHED;
            PG8_STAGE(PG8_SB(0, 1), b2 + hstep, voffB);
            PG8_WAIT_V(6); PG8_BAR; PG8_MMA(1, 1, At, B1); PG8_BAR;
            PG8_LDB(B0, 1, 0); PG8_SCHED; PG8_LDA(At, 1, 0); PG8_STAGE(PG8_SA(0, 1), a2 + hstep, voffA);
            PG8_WAIT_L(8); PG8_BAR; PG8_WAIT_L(0); PG8_MMA(0, 0, At, B0); PG8_BAR; PG8_SCHED;
            PG8_LDB(B1, 1, 1); PG8_STAGE(PG8_SB(1, 0), b3, voffB);
            PG8_BAR; PG8_WAIT_L(0); PG8_MMA(0, 1, At, B1); PG8_BAR;
            PG8_LDA(At, 1, 1); PG8_STAGE(PG8_SA(1, 0), a3, voffA);
            PG8_BAR; PG8_WAIT_L(0); PG8_MMA(1, 0, At, B0); PG8_BAR; PG8_SCHED;
            PG8_STAGE(PG8_SB(1, 1), b3 + hstep, voffB);
            PG8_WAIT_V(6); PG8_BAR; PG8_MMA(1, 1, At, B1); PG8_BAR;
            }
            if constexpr (Epi::HAS_MID) { if (t + 2 < nt && ((t + 2) & 7) == 0) E.mid(acc, cur, (t + 2) >> 3, wr, wc, fr, fq); }
        }
        if constexpr (ALIGN_EPI) { if (wr == 0) PG8_BAR; }
        if constexpr (!Epi::AFTER_DRAIN) { E(acc, cur, wr, wc, fr, fq); S.done(cur); }
        if (!has_next) break;
#pragma unroll
        for (int a = 0; a < 2; ++a)
#pragma unroll
            for (int b = 0; b < 2; ++b)
#pragma unroll
                for (int m = 0; m < 4; ++m)
#pragma unroll
                    for (int n = 0; n < 2; ++n) acc[a][b][m][n] = (f32x4){0.f, 0.f, 0.f, 0.f};
        cur = nxt; cA = nA; cB = nB; ++ui;
        if constexpr (ALIGN_EPI) { if (wr == 1) PG8_BAR; }
    }
    PG8_WAIT_V(0);
    if constexpr (!ALIGN_EPI) { if (wr == 0) PG8_BAR; }
    PG8_BAR;
    if constexpr (Epi::AFTER_DRAIN) { E.fused(acc, cur, wr, wc, fr, fq, lds, wid, lane); S.done(cur); }
#undef PG8_SA
#undef PG8_SB
#undef PG8_STAGE
#undef PG8_LDA
#undef PG8_LDB
#undef PG8_MMA
#undef PG8_WAIT_V
#undef PG8_WAIT_L
#undef PG8_BAR
#undef PG8_SCHED
}
}
#ifndef PG8_SP2
#define PG8_SP2 true
#endif
#ifndef PG8_ALIGN
#define PG8_ALIGN true
#endif
#ifndef ATTN_NAIVE
#define ATTN_NAIVE 0
#endif
#ifndef MK_ONE_LAUNCH
#define MK_ONE_LAUNCH 1
#endif

constexpr int BATCH = 2, SEQ = 16384, D = 1024, DEPTH = 2, HD = 64, NH = 8, FF = 4096;
constexpr int M = BATCH * SEQ;
constexpr int NIN = 6656;
constexpr int KMRG = 1536;
constexpr float RMS_EPS = 1e-6f;
constexpr int NWAVES = 8;

constexpr size_t MiB = 1u << 20;
constexpr size_t WS_CTL = 0, CTL_ZERO_BYTES = 1 * MiB;
constexpr size_t WS_WIN = 1 * MiB, WS_WBR = 14 * MiB, WS_WO = 17 * MiB, WS_W1 = 19 * MiB, WS_W2 = 27 * MiB;
constexpr size_t WS_X1 = 35 * MiB;
constexpr size_t WS_X2 = 131 * MiB;
constexpr size_t WS_G = 259 * MiB;
constexpr size_t WS_HB = 355 * MiB;
constexpr size_t WS_UC = 419 * MiB;
constexpr size_t WS_PO = 355 * MiB;
constexpr size_t WS_PL = 451 * MiB;
constexpr size_t WS_DO = 454 * MiB;
constexpr size_t WS_DL = 486 * MiB;
constexpr size_t WS_LIST = 487 * MiB;
constexpr size_t WS_KBAR = 503 * MiB;
constexpr size_t WS_END = 504 * MiB;
constexpr size_t WS_MB = 131 * MiB;
constexpr size_t WS_Y = 195 * MiB;
constexpr size_t WS_H = 35 * MiB;
constexpr size_t WS_Y2 = 291 * MiB;
constexpr int CW_BAR = 4096;
constexpr int CW_KMAX = 8192;
constexpr int CW_GCNT = 16384;
constexpr int PREF_OFF = 40960;

constexpr int RING_OFF = 0, RING_BYTES = 131072;
constexpr int LDSCTL_OFF = RING_BYTES, MISC_OFF = LDSCTL_OFF + 320;
constexpr int LDS_BYTES = 147456;

#define GAS __attribute__((address_space(1)))
#define LAS __attribute__((address_space(3)))
typedef unsigned short bf16;
typedef unsigned v4u __attribute__((ext_vector_type(4)));
typedef unsigned v2u __attribute__((ext_vector_type(2)));
typedef float f32x4 __attribute__((ext_vector_type(4)));
typedef GAS unsigned gu32;
#define RLX_AGENT __ATOMIC_RELAXED, __HIP_MEMORY_SCOPE_AGENT
#define LDS_WAIT() asm volatile("s_waitcnt lgkmcnt(0)" ::: "memory")
__device__ __forceinline__ unsigned f2bf(float f) { unsigned u = __builtin_bit_cast(unsigned, f); return (u + 0x7fffu + ((u >> 16) & 1u)) >> 16; }
__device__ __forceinline__ unsigned pk2(float lo, float hi) { return f2bf(lo) | (f2bf(hi) << 16); }
__device__ __forceinline__ float bflo(unsigned w) { return __builtin_bit_cast(float, w << 16); }
__device__ __forceinline__ float bfhi(unsigned w) { return __builtin_bit_cast(float, w & 0xffff0000u); }
__device__ __forceinline__ float bf1(bf16 b) { return __builtin_bit_cast(float, ((unsigned)b) << 16); }
__device__ __forceinline__ float wave_sum(float v) {
#pragma unroll
    for (int o = 1; o < 64; o <<= 1) v += __shfl_xor(v, o);
    return v;
}
__device__ __forceinline__ float wave_max(float v) {
#pragma unroll
    for (int o = 1; o < 64; o <<= 1) v = fmaxf(v, __shfl_xor(v, o));
    return v;
}

#define XB_TMO      128
#define XB_XCNT(j)  (256  + 64 * (j))
#define XB_XSUB(j)  (1280 + 64 * (j))
#define XB_XGEN(j)  (2304 + 64 * (j))
#define XB_TOP      3328
#define XB_TOPGEN   3392
#define XCD_BAR_WORDS 3456
#define XB_SPIN_CAP (1u << 18)

__device__ __forceinline__ unsigned xb_ld(unsigned* p)              { return __hip_atomic_load(p, __ATOMIC_RELAXED, __HIP_MEMORY_SCOPE_AGENT); }
__device__ __forceinline__ unsigned xb_add(unsigned* p, unsigned v) { return __hip_atomic_fetch_add(p, v, __ATOMIC_RELAXED, __HIP_MEMORY_SCOPE_AGENT); }
__device__ __forceinline__ unsigned xb_xcc_id() { return (unsigned)__builtin_amdgcn_s_getreg((3 << 11) | 20) & 0xFu; }
#define XB_SPIN(cond, bar) do { unsigned _sp = 0; while (cond) { __builtin_amdgcn_s_sleep(1); \
    if ((++_sp & 255u) == 0u) { if (xb_ld(&(bar)[XB_TMO])) break; if (_sp > XB_SPIN_CAP) { atomicAdd(&(bar)[XB_TMO], 1u); break; } } } } while (0)

struct XcdBarrier {
    unsigned* bar; unsigned x;
    volatile LAS unsigned* st;
};

__device__ __forceinline__ XcdBarrier xcd_barrier_post(unsigned* bar, volatile LAS unsigned* st) {
    XcdBarrier b; b.bar = bar; b.x = xb_xcc_id(); b.st = st;
    if (threadIdx.x == 0) (void)xb_add(&bar[XB_XCNT(b.x)], 1u);
    return b;
}
__device__ __forceinline__ void xcd_barrier_complete(unsigned* bar, unsigned x, unsigned& nloc, unsigned& nx) {
    const unsigned G = gridDim.x * gridDim.y * gridDim.z;
    unsigned sum, cnt, mine, sp = 0u;
    for (;;) {
        sum = 0u; cnt = 0u; mine = 0u;
#pragma unroll
        for (unsigned j = 0; j < 16; ++j) { const unsigned c = xb_ld(&bar[XB_XCNT(j)]); sum += c; cnt += (c > 0u) ? 1u : 0u; mine = (j == x) ? c : mine; }
        if (sum == G) break;
        __builtin_amdgcn_s_sleep(1);
        if ((++sp & 255u) == 0u) { if (xb_ld(&bar[XB_TMO])) break; if (sp > XB_SPIN_CAP) { atomicAdd(&bar[XB_TMO], 1u); break; } }
    }
    nloc = mine > 0u ? mine : 1u; nx = cnt > 0u ? cnt : 1u;
}

__device__ __forceinline__ void xcd_barrier(const XcdBarrier& b) {
    asm volatile("s_waitcnt vmcnt(0)" ::: "memory");
    __syncthreads();
    if (threadIdx.x == 0) {
        unsigned* bar = b.bar;
        __builtin_amdgcn_s_waitcnt(0);
        unsigned nloc = b.st[0], nx = b.st[1];
        if (nloc == 0u) { xcd_barrier_complete(bar, b.x, nloc, nx); b.st[0] = nloc; b.st[1] = nx; }
        const unsigned old = xb_add(&bar[XB_XSUB(b.x)], 1u);
        const unsigned gen = old / nloc;
        if (old + 1u == (gen + 1u) * nloc) {
            __builtin_amdgcn_fence(__ATOMIC_RELEASE, "agent");
            asm volatile("s_waitcnt vmcnt(0)" ::: "memory");
            const unsigned og = xb_add(&bar[XB_TOP], 1u);
            const unsigned tg = og / nx;
            if (og + 1u == (tg + 1u) * nx) xb_add(&bar[XB_TOPGEN], 1u);
            else XB_SPIN(xb_ld(&bar[XB_TOPGEN]) == tg, bar);
            __builtin_amdgcn_fence(__ATOMIC_ACQUIRE, "agent");
            xb_add(&bar[XB_XGEN(b.x)], 1u);
            asm volatile("s_waitcnt vmcnt(0)" ::: "memory");
        } else {
            XB_SPIN(xb_ld(&bar[XB_XGEN(b.x)]) == gen, bar);
            __builtin_amdgcn_fence(__ATOMIC_ACQUIRE, "agent");
            asm volatile("s_waitcnt vmcnt(0)" ::: "memory");
        }
    }
    __syncthreads();
}

__device__ __forceinline__ void tr_item(const float* W, int ldw, int k0, int n0src, bf16* WT, int ldt, int rowdst0, int kdst0, LAS float* scr, int lane) {
#pragma unroll 8
    for (int i = 0; i < 32; ++i) { const int kk = 2 * i + (lane >> 5); scr[kk * 33 + (lane & 31)] = W[(size_t)(k0 + kk) * ldw + n0src + (lane & 31)]; }
    LDS_WAIT(); asm volatile("" ::: "memory");
    const int c = lane & 7;
#pragma unroll
    for (int j = 0; j < 4; ++j) { const int n = (lane >> 3) + 8 * j; const LAS float* s = scr + (8 * c) * 33 + n;
        v4u o; o.x = pk2(s[0 * 33], s[1 * 33]); o.y = pk2(s[2 * 33], s[3 * 33]); o.z = pk2(s[4 * 33], s[5 * 33]); o.w = pk2(s[6 * 33], s[7 * 33]);
        *(GAS v4u*)(WT + (size_t)(rowdst0 + n) * ldt + kdst0 + k0 + 8 * c) = o; }
    LDS_WAIT(); asm volatile("" ::: "memory");
}
__device__ __forceinline__ void convert_layer(const float* const* in, unsigned char* ws, int l, LAS unsigned char* lds, int wave, int lane, int gw, int NGW, int gtid, int NTH) {
    const float* Win = in[1] + (size_t)l * D * NIN; const float* Wa = in[2] + (size_t)l * 512 * D; const float* Wb = in[3] + (size_t)l * 512 * D; const float* Wc = in[4] + (size_t)l * 512 * D;
    const float* Wo = in[5] + (size_t)l * D * D; const float* Wp = in[6] + (size_t)l * 4 * 128 * 128; const float* Ps = in[7] + (size_t)l * 512;
    const float* W1 = in[12] + (size_t)l * D * FF; const float* W2 = in[13] + (size_t)l * FF * D;
    bf16* WinT = (bf16*)(ws + WS_WIN); bf16* WbrT = (bf16*)(ws + WS_WBR); bf16* WoT = (bf16*)(ws + WS_WO); bf16* W1T = (bf16*)(ws + WS_W1); bf16* W2T = (bf16*)(ws + WS_W2);
    LAS float* scr = (LAS float*)(lds + RING_OFF + wave * 16384);
    constexpr int I_IN = 16 * 208, I_BR = 8 * 32, I_O = 16 * 32, I_1 = 16 * 128, I_2 = 64 * 32, NIT = I_IN + 2 * I_BR + I_O + I_1 + I_2;
    for (int it = gw; it < NIT; it += NGW) {
        int r = it;
        if (r < I_IN) { const int kb = r / 208, nb = r % 208, n0 = 32 * nb, db = n0 >> 9;
            const int sb = db == 1 ? 3 : db == 2 ? 6 : db == 3 ? 1 : db == 4 ? 2 : db == 5 ? 4 : db == 6 ? 5 : db;
            tr_item(Win, NIN, 64 * kb, sb * 512 + (n0 & 511), WinT, D, n0, 0, scr, lane); continue; } r -= I_IN;
        if (r < I_BR) { tr_item(Wa, D, 64 * (r / 32), 32 * (r % 32), WbrT, KMRG, 32 * (r % 32), 0, scr, lane); continue; } r -= I_BR;
        if (r < I_BR) { tr_item(Wb, D, 64 * (r / 32), 32 * (r % 32), WbrT, KMRG, 32 * (r % 32), 512, scr, lane); continue; } r -= I_BR;
        if (r < I_O) { tr_item(Wo, D, 64 * (r / 32), 32 * (r % 32), WoT, D, 32 * (r % 32), 0, scr, lane); continue; } r -= I_O;
        if (r < I_1) { tr_item(W1, FF, 64 * (r / 128), 32 * (r % 128), W1T, D, 32 * (r % 128), 0, scr, lane); continue; } r -= I_1;
        tr_item(W2, D, 64 * (r / 32), 32 * (r % 32), W2T, FF, 32 * (r % 32), 0, scr, lane);
    }
    for (int i = gtid; i < 65536; i += NTH) {
        const int n = i & 1023, rest = i >> 10, g = rest >> 4, cc = rest & 15;
        float a[8];
#pragma unroll
        for (int j = 0; j < 8; ++j) a[j] = 0.f;
        const float* wp = Wp + (size_t)(g * 128 + 8 * cc) * 128;
        for (int d = 0; d < 128; ++d) { const float wsv = Wc[(size_t)(g * 128 + d) * D + n] * Ps[g * 128 + d];
#pragma unroll
            for (int j = 0; j < 8; ++j) a[j] += wp[j * 128 + d] * wsv; }
        v4u o; o.x = pk2(a[0], a[1]); o.y = pk2(a[2], a[3]); o.z = pk2(a[4], a[5]); o.w = pk2(a[6], a[7]);
        *(GAS v4u*)(WbrT + (size_t)n * KMRG + 1024 + g * 128 + 8 * cc) = o;
    }
}
__device__ __forceinline__ void row_norm_bf16(const float* xrow, const float* g, bf16* orow, int lane) {
    const GAS f32x4* xr = (const GAS f32x4*)xrow + lane; const GAS f32x4* gr = (const GAS f32x4*)g + lane;
    f32x4 v[4]; float s = 0.f;
#pragma unroll
    for (int j = 0; j < 4; ++j) { v[j] = xr[64 * j]; s += (v[j].x * v[j].x + v[j].y * v[j].y) + (v[j].z * v[j].z + v[j].w * v[j].w); }
    const float r = 1.0f / sqrtf(wave_sum(s) * (1.0f / D) + RMS_EPS);
    GAS v2u* o8 = (GAS v2u*)orow + lane;
#pragma unroll
    for (int j = 0; j < 4; ++j) { const f32x4 gg = gr[64 * j]; v2u w; w.x = pk2(v[j].x * r * gg.x, v[j].y * r * gg.y); w.y = pk2(v[j].z * r * gg.z, v[j].w * r * gg.w); o8[64 * j] = w; }
}
__device__ __forceinline__ void row_post(const bf16* yrow, const float* xin, float* xout, const float* gpost, bf16* hb, const float* gnext, int lane) {
    const GAS v2u* yr = (const GAS v2u*)yrow + lane;
    f32x4 y[4]; float s = 0.f;
#pragma unroll
    for (int j = 0; j < 4; ++j) { const v2u w = yr[64 * j]; y[j] = (f32x4){bflo(w.x), bfhi(w.x), bflo(w.y), bfhi(w.y)}; s += (y[j].x * y[j].x + y[j].y * y[j].y) + (y[j].z * y[j].z + y[j].w * y[j].w); }
    const float r = 1.0f / sqrtf(wave_sum(s) * (1.0f / D) + RMS_EPS);
    f32x4 x1[4]; float s2 = 0.f;
#pragma unroll
    for (int j = 0; j < 4; ++j) { const f32x4 xi = ((const GAS f32x4*)xin)[lane + 64 * j], gp = ((const GAS f32x4*)gpost)[lane + 64 * j];
        x1[j] = xi + y[j] * r * gp; ((GAS f32x4*)xout)[lane + 64 * j] = x1[j];
        s2 += (x1[j].x * x1[j].x + x1[j].y * x1[j].y) + (x1[j].z * x1[j].z + x1[j].w * x1[j].w); }
    if (hb) {
        const float r2 = 1.0f / sqrtf(wave_sum(s2) * (1.0f / D) + RMS_EPS);
        GAS v2u* o8 = (GAS v2u*)hb + lane;
#pragma unroll
        for (int j = 0; j < 4; ++j) { const f32x4 gn = ((const GAS f32x4*)gnext)[lane + 64 * j]; v2u w; w.x = pk2(x1[j].x * r2 * gn.x, x1[j].y * r2 * gn.y); w.y = pk2(x1[j].z * r2 * gn.z, x1[j].w * r2 * gn.w); o8[64 * j] = w; }
    }
}
__device__ __forceinline__ void kstat_job(const bf16* X2, float* kbar, gu32* kmax, int job, int lane) {
    const int mixer = job >> 10, b = (job >> 9) & 1, h = (job >> 6) & 7, j = job & 63;
    const bf16* rows = X2 + (size_t)(b * SEQ + 256 * j) * 2048 + mixer * 1024 + h * 64;
    const int piece = lane & 7, rg = lane >> 3;
    float a[8]; float mx = 0.f;
#pragma unroll
    for (int i = 0; i < 8; ++i) a[i] = 0.f;
    for (int it = 0; it < 32; ++it) {
        const v4u w = *(const GAS v4u*)(rows + (size_t)(it * 8 + rg) * 2048 + piece * 8);
        const float v0 = bflo(w.x), v1 = bfhi(w.x), v2 = bflo(w.y), v3 = bfhi(w.y), v4 = bflo(w.z), v5 = bfhi(w.z), v6 = bflo(w.w), v7 = bfhi(w.w);
        a[0] += v0; a[1] += v1; a[2] += v2; a[3] += v3; a[4] += v4; a[5] += v5; a[6] += v6; a[7] += v7;
        float ss = (v0 * v0 + v1 * v1) + (v2 * v2 + v3 * v3) + (v4 * v4 + v5 * v5) + (v6 * v6 + v7 * v7);
        ss += __shfl_xor(ss, 1); ss += __shfl_xor(ss, 2); ss += __shfl_xor(ss, 4);
        mx = fmaxf(mx, ss);
    }
#pragma unroll
    for (int i = 0; i < 8; ++i) { a[i] += __shfl_xor(a[i], 8); a[i] += __shfl_xor(a[i], 16); a[i] += __shfl_xor(a[i], 32); }
    if (mixer == 0 && lane < 8) {
        float* o = kbar + ((size_t)((b * 8 + h) * 64 + j)) * 64 + piece * 8;
#pragma unroll
        for (int i = 0; i < 8; ++i) o[i] = a[i] * (1.0f / 256.0f);
    }
    mx = wave_max(mx);
    if (lane == 0) __hip_atomic_fetch_max(kmax + mixer * 16 + b * 8 + h, __builtin_bit_cast(unsigned, mx), RLX_AGENT);
}
__device__ __forceinline__ void pool_items(const bf16* UC, bf16* X1, int gtid, int NTH) {
    for (int i = gtid; i < M * 64; i += NTH) {
        const int t = i >> 6, c0 = (i & 63) * 8, g = c0 >> 7, w = 2 << g, tp = t & (SEQ - 1), cnt = (tp + 1) < w ? (tp + 1) : w;
        float s[8], self[8];
#pragma unroll
        for (int j = 0; j < 8; ++j) s[j] = 0.f;
        for (int k = 0; k < cnt; ++k) {
            const v4u v = *(const GAS v4u*)(UC + (size_t)(t - k) * 512 + c0);
            const float f[8] = {bflo(v.x), bfhi(v.x), bflo(v.y), bfhi(v.y), bflo(v.z), bfhi(v.z), bflo(v.w), bfhi(v.w)};
#pragma unroll
            for (int j = 0; j < 8; ++j) { s[j] += f[j]; if (k == 0) self[j] = f[j]; }
        }
        const float inv = 1.0f / (float)cnt;
        v4u o; o.x = pk2(s[0] * inv - self[0], s[1] * inv - self[1]); o.y = pk2(s[2] * inv - self[2], s[3] * inv - self[3]);
        o.z = pk2(s[4] * inv - self[4], s[5] * inv - self[5]); o.w = pk2(s[6] * inv - self[6], s[7] * inv - self[7]);
        *(GAS v4u*)(X1 + (size_t)t * KMRG + 1024 + c0) = o;
    }
}

__device__ __forceinline__ void nv_chunk(const float (&q)[64], const bf16* Kb, const bf16* Vb, int pos0, int pstride, bool valid, int lane, float& m_run, float& l_lane, float& acc) {
    int pos = pos0 + lane * pstride; pos = pos < 0 ? 0 : pos;
    const GAS v4u* kr = (const GAS v4u*)(Kb + (size_t)pos * 2048);
    float s = 0.f;
#pragma unroll
    for (int c = 0; c < 8; ++c) { const v4u w = kr[c];
        s += q[8 * c] * bflo(w.x) + q[8 * c + 1] * bfhi(w.x) + q[8 * c + 2] * bflo(w.y) + q[8 * c + 3] * bfhi(w.y) + q[8 * c + 4] * bflo(w.z) + q[8 * c + 5] * bfhi(w.z) + q[8 * c + 6] * bflo(w.w) + q[8 * c + 7] * bfhi(w.w); }
    s = valid ? s : -1e30f;
    const float cm = wave_max(s), mn = fmaxf(m_run, cm), alpha = __builtin_amdgcn_exp2f(m_run - mn);
    const float p = valid ? __builtin_amdgcn_exp2f(s - mn) : 0.f;
    l_lane = l_lane * alpha + p;
    float a = 0.f;
#pragma unroll 16
    for (int kk = 0; kk < 64; ++kk) {
        const float pk = __builtin_bit_cast(float, __builtin_amdgcn_readlane(__builtin_bit_cast(int, p), kk));
        int pp = pos0 + kk * pstride; pp = pp < 0 ? 0 : pp;
        a += pk * bf1(Vb[(size_t)pp * 2048 + lane]);
    }
    acc = acc * alpha + a; m_run = mn;
}
__device__ __forceinline__ void nv_load_q(float (&q)[64], const bf16* qrow) {
#pragma unroll
    for (int c = 0; c < 8; ++c) { const v4u w = ((const GAS v4u*)qrow)[c];
        q[8 * c] = bflo(w.x); q[8 * c + 1] = bfhi(w.x); q[8 * c + 2] = bflo(w.y); q[8 * c + 3] = bfhi(w.y); q[8 * c + 4] = bflo(w.z); q[8 * c + 5] = bfhi(w.z); q[8 * c + 6] = bflo(w.w); q[8 * c + 7] = bfhi(w.w); }
}
__device__ __forceinline__ void nv_moba(bf16* X1, const bf16* X2, const float* kbar, int b, int t, int h, int lane) {
    bf16* qrow = X1 + (size_t)(b * SEQ + t) * KMRG + h * 64;
    float q[64]; nv_load_q(q, qrow);
    const bf16* Kb = X2 + (size_t)b * SEQ * 2048 + h * 64; const bf16* Vb = Kb + 512;
    const int n = t >> 8;
    float sc = -INFINITY;
    if (lane < n) { const GAS f32x4* kb = (const GAS f32x4*)(kbar + ((size_t)((b * 8 + h) * 64 + lane)) * 64); float s = 0.f;
#pragma unroll
        for (int c = 0; c < 16; ++c) { const f32x4 w = kb[c]; s += q[4 * c] * w.x + q[4 * c + 1] * w.y + q[4 * c + 2] * w.z + q[4 * c + 3] * w.w; }
        sc = s; }
    float m_run = -1e30f, l_lane = 0.f, acc = 0.f;
    for (int r = 0; r < 3; ++r) {
        float bv = sc; int bi = lane;
#pragma unroll
        for (int o = 1; o < 64; o <<= 1) { const float ov = __shfl_xor(bv, o); const int oi = __shfl_xor(bi, o); if (ov > bv || (ov == bv && oi < bi)) { bv = ov; bi = oi; } }
        if (!(bv > -INFINITY)) break;
        bi = __builtin_amdgcn_readfirstlane(bi);
        if (lane == bi) sc = -INFINITY;
        for (int c = 0; c < 4; ++c) nv_chunk(q, Kb, Vb, bi * 256 + 64 * c, 1, true, lane, m_run, l_lane, acc);
    }
    const int nc = ((t & 255) >> 6) + 1;
    for (int c = 0; c < nc; ++c) { const int pos0 = n * 256 + 64 * c; nv_chunk(q, Kb, Vb, pos0, 1, (pos0 + lane) <= t, lane, m_run, l_lane, acc); }
    const float o = acc / wave_sum(l_lane);
    qrow[lane] = (bf16)f2bf(o);
}
__device__ __forceinline__ void nv_dil(bf16* X1, const bf16* X2, int b, int t, int h, int lane) {
    bf16* qrow = X1 + (size_t)(b * SEQ + t) * KMRG + 512 + h * 64;
    float q[64]; nv_load_q(q, qrow);
    const bf16* Kb = X2 + (size_t)b * SEQ * 2048 + 1024 + h * 64; const bf16* Vb = Kb + 512;
    float m_run = -1e30f, l_lane = 0.f, acc = 0.f;
#pragma unroll
    for (int p = 0; p < 3; ++p) { const int d = p == 0 ? 1 : (p == 1 ? 4 : 16);
        for (int c = 0; c < 3; ++c) { const int mm = 64 * c + lane; nv_chunk(q, Kb, Vb, t - 64 * c * d, -d, (mm <= 128) && (t - mm * d >= 0), lane, m_run, l_lane, acc); } }
    const float o = acc / wave_sum(l_lane);
    qrow[lane] = (bf16)f2bf(o);
}

typedef short bf16x8 __attribute__((ext_vector_type(8)));
typedef short s16x4 __attribute__((ext_vector_type(4)));
typedef float f32x16 __attribute__((ext_vector_type(16)));
typedef float f32x2_t __attribute__((ext_vector_type(2)));
typedef __bf16 bf16x2_t __attribute__((ext_vector_type(2)));
#define MFMA32(a, b, c) __builtin_amdgcn_mfma_f32_32x32x16_bf16((a), (b), (c), 0, 0, 0)
constexpr int VT_PITCH = 144, VT_BYTES = 32 * VT_PITCH;
constexpr int LIST_PER_BH = 256 * 2016;
__device__ __forceinline__ int list_off(int j) { return 256 * (63 * j - (j * (j - 1)) / 2); }
__device__ __forceinline__ unsigned cvtpk(float lo, float hi) { f32x2_t v = {lo, hi}; bf16x2_t b = __builtin_convertvector(v, bf16x2_t); return __builtin_bit_cast(unsigned, b); }
__device__ __forceinline__ s16x4 vtr(LAS const char* p) { return __builtin_bit_cast(s16x4, __builtin_amdgcn_ds_read_tr16_b64_v4i16((LAS s16x4*)p)); }

__device__ __forceinline__ void at_load(const bf16* Kb, const bf16* Vb, int p0, int ps, int r32, int hi, int lane, bf16x8 (&kf)[4], v4u (&vr)[4]) {
    int pk = p0 + r32 * ps; pk = pk < 0 ? 0 : pk;
    const bf16* kr = Kb + (size_t)pk * 2048 + 8 * hi;
#pragma unroll
    for (int s = 0; s < 4; ++s) kf[s] = *(const GAS bf16x8*)(kr + 16 * s);
#pragma unroll
    for (int it = 0; it < 4; ++it) { const int c = it * 64 + lane, key = c >> 3, piece = c & 7; int pv = p0 + key * ps; pv = pv < 0 ? 0 : pv;
        vr[it] = *(const GAS v4u*)(Vb + (size_t)pv * 2048 + piece * 8); }
}
__device__ __forceinline__ void at_stage_v(LAS char* vl, const v4u (&vr)[4], int lane) {
#pragma unroll
    for (int it = 0; it < 4; ++it) { const int c = it * 64 + lane, key = c >> 3, piece = c & 7; *(LAS v4u*)(vl + key * VT_PITCH + piece * 16) = vr[it]; }
}
template <bool MASK>
__device__ __forceinline__ void at_compute(const bf16x8 (&qf)[4], const bf16x8 (&kf)[4], LAS const char* vl, float shift, int kbase, int klo, int khi, int hi, int lane, f32x16& o0, f32x16& o1, float& l) {
    f32x16 s;
#pragma unroll
    for (int i = 0; i < 16; ++i) s[i] = 0.f;
#pragma unroll
    for (int k = 0; k < 4; ++k) s = MFMA32(kf[k], qf[k], s);
    float p[16];
#pragma unroll
    for (int i = 0; i < 16; ++i) { float pe = __builtin_amdgcn_exp2f(s[i] - shift);
        if (MASK) { const int kidx = kbase + (i & 3) + 8 * (i >> 2) + 4 * hi; pe = (kidx >= klo && kidx <= khi) ? pe : 0.f; }
        p[i] = pe; l += pe; }
    bf16x8 pf[2];
#pragma unroll
    for (int sp = 0; sp < 2; ++sp) { v4u w; w.x = cvtpk(p[8 * sp], p[8 * sp + 1]); w.y = cvtpk(p[8 * sp + 2], p[8 * sp + 3]); w.z = cvtpk(p[8 * sp + 4], p[8 * sp + 5]); w.w = cvtpk(p[8 * sp + 6], p[8 * sp + 7]); pf[sp] = __builtin_bit_cast(bf16x8, w); }
    const int q4 = (lane & 15) >> 2, p4 = lane & 3, blk = (lane >> 4) & 1;
    LAS const char* vb = vl + (4 * hi + q4) * VT_PITCH + (16 * blk + 4 * p4) * 2;
#pragma unroll
    for (int sp = 0; sp < 2; ++sp) {
        const s16x4 a0 = vtr(vb + (16 * sp) * VT_PITCH), a1 = vtr(vb + (16 * sp + 8) * VT_PITCH);
        const s16x4 b0 = vtr(vb + (16 * sp) * VT_PITCH + 64), b1 = vtr(vb + (16 * sp + 8) * VT_PITCH + 64);
        const bf16x8 v0 = __builtin_shufflevector(a0, a1, 0, 1, 2, 3, 4, 5, 6, 7), v1 = __builtin_shufflevector(b0, b1, 0, 1, 2, 3, 4, 5, 6, 7);
        o0 = MFMA32(v0, pf[sp], o0); o1 = MFMA32(v1, pf[sp], o1);
    }
}
template <int MASKMODE>
__device__ __forceinline__ void at_run(const bf16x8 (&qf)[4], float shift, const bf16* Kb, const bf16* Vb, int p0, int ps, int kt_lo, int kt_hi, int klo, int khi, LAS char* vl, int lane, f32x16& o0, f32x16& o1, float& l) {
    const int r32 = lane & 31, hi = lane >> 5;
    if (kt_lo >= kt_hi) return;
    bf16x8 kf[4], kn[4]; v4u vr[4], vn[4];
    at_load(Kb, Vb, p0 + 32 * kt_lo * ps, ps, r32, hi, lane, kf, vr);
    for (int kt = kt_lo; kt < kt_hi; ++kt) {
        at_stage_v(vl, vr, lane);
        const bool more = kt + 1 < kt_hi;
        if (more) at_load(Kb, Vb, p0 + 32 * (kt + 1) * ps, ps, r32, hi, lane, kn, vn);
        if (MASKMODE == 1 || (MASKMODE == 2 && !more)) at_compute<true>(qf, kf, vl, shift, 32 * kt, klo, khi, hi, lane, o0, o1, l);
        else at_compute<false>(qf, kf, vl, shift, 32 * kt, klo, khi, hi, lane, o0, o1, l);
        if (more) {
#pragma unroll
            for (int k = 0; k < 4; ++k) { kf[k] = kn[k]; vr[k] = vn[k]; } }
    }
}
__device__ __forceinline__ float at_load_q(const bf16* qrow, int hi, float kmax2, bf16x8 (&qf)[4]) {
    float ss = 0.f;
#pragma unroll
    for (int s = 0; s < 4; ++s) { qf[s] = *(const GAS bf16x8*)(qrow + 16 * s + 8 * hi);
#pragma unroll
        for (int j = 0; j < 8; ++j) { const float f = bf1((bf16)qf[s][j]); ss += f * f; } }
    ss += __shfl_xor(ss, 32);
    return sqrtf(ss * kmax2) * 1.0002f + 1e-6f;
}
#define AT_ZERO(o0, o1, l) do { _Pragma("unroll") for (int _i = 0; _i < 16; ++_i) { o0[_i] = 0.f; o1[_i] = 0.f; } l = 0.f; } while (0)
__device__ __forceinline__ void at_store_bf16(bf16* row, int hi, const f32x16& o0, const f32x16& o1, float sc) {
#pragma unroll
    for (int g = 0; g < 4; ++g) { v2u w; w.x = cvtpk(o0[4 * g] * sc, o0[4 * g + 1] * sc); w.y = cvtpk(o0[4 * g + 2] * sc, o0[4 * g + 3] * sc); *(GAS v2u*)(row + 8 * g + 4 * hi) = w;
        v2u x; x.x = cvtpk(o1[4 * g] * sc, o1[4 * g + 1] * sc); x.y = cvtpk(o1[4 * g + 2] * sc, o1[4 * g + 3] * sc); *(GAS v2u*)(row + 32 + 8 * g + 4 * hi) = x; }
}
template <bool SC1>
__device__ __forceinline__ void at_add_bf16(const bf16* row, int hi, f32x16& o0, f32x16& o1) {
#pragma unroll
    for (int g = 0; g < 4; ++g) {
        unsigned long long a, b;
        if (SC1) { a = __hip_atomic_load((const GAS unsigned long long*)(row + 8 * g + 4 * hi), RLX_AGENT); b = __hip_atomic_load((const GAS unsigned long long*)(row + 32 + 8 * g + 4 * hi), RLX_AGENT); }
        else { a = *(const GAS unsigned long long*)(row + 8 * g + 4 * hi); b = *(const GAS unsigned long long*)(row + 32 + 8 * g + 4 * hi); }
        const unsigned a0 = (unsigned)a, a1 = (unsigned)(a >> 32), b0 = (unsigned)b, b1 = (unsigned)(b >> 32);
        o0[4 * g] += bflo(a0); o0[4 * g + 1] += bfhi(a0); o0[4 * g + 2] += bflo(a1); o0[4 * g + 3] += bfhi(a1);
        o1[4 * g] += bflo(b0); o1[4 * g + 1] += bfhi(b0); o1[4 * g + 2] += bflo(b1); o1[4 * g + 3] += bfhi(b1); }
}

__device__ __forceinline__ void moba_gate_job(const bf16* X1, const float* kbar, gu32* gcnt, bf16* LIST, int job, LAS unsigned char* lds, int tid) {
    const int bh = job >> 5, c = job & 31, b = bh >> 3, h = bh & 7, t = 512 * c + tid, n = t >> 8, nbmax = 2 * c + 1;
    LAS float* kb = (LAS float*)lds;
    LAS unsigned* hist = (LAS unsigned*)(lds + 16384); LAS unsigned* base = hist + 64; LAS unsigned* cur = hist + 128;
    __syncthreads();
    for (int i = tid; i < nbmax * 16; i += NWAVES * 64) ((LAS f32x4*)kb)[i] = ((const GAS f32x4*)(kbar + (size_t)bh * 4096))[i];
    if (tid < 64) { hist[tid] = 0u; cur[tid] = 0u; }
    __syncthreads();
    float q[64]; nv_load_q(q, X1 + (size_t)(b * SEQ + t) * KMRG + h * 64);
    float v0 = -INFINITY, v1 = -INFINITY, v2 = -INFINITY; int i0 = 0, i1 = 0, i2 = 0;
    for (int j = 0; j < n; ++j) {
        const LAS f32x4* kr = (const LAS f32x4*)(kb + j * 64); float s = 0.f;
#pragma unroll
        for (int cc = 0; cc < 16; ++cc) { const f32x4 w = kr[cc]; s += q[4 * cc] * w.x + q[4 * cc + 1] * w.y + q[4 * cc + 2] * w.z + q[4 * cc + 3] * w.w; }
        if (s > v2) { if (s > v1) { v2 = v1; i2 = i1; if (s > v0) { v1 = v0; i1 = i0; v0 = s; i0 = j; } else { v1 = s; i1 = j; } } else { v2 = s; i2 = j; } }
    }
    const int nv = n < 3 ? n : 3;
    if (nv > 0) __hip_atomic_fetch_add(hist + i0, 1u, __ATOMIC_RELAXED, __HIP_MEMORY_SCOPE_WORKGROUP);
    if (nv > 1) __hip_atomic_fetch_add(hist + i1, 1u, __ATOMIC_RELAXED, __HIP_MEMORY_SCOPE_WORKGROUP);
    if (nv > 2) __hip_atomic_fetch_add(hist + i2, 1u, __ATOMIC_RELAXED, __HIP_MEMORY_SCOPE_WORKGROUP);
    __syncthreads();
    if (tid < 64) { const unsigned hcount = hist[tid]; base[tid] = hcount ? __hip_atomic_fetch_add(gcnt + bh * 64 + tid, hcount, RLX_AGENT) : 0u; }
    __syncthreads();
    bf16* Lb = LIST + (size_t)bh * LIST_PER_BH;
    if (nv > 0) { const unsigned pos = base[i0] + __hip_atomic_fetch_add(cur + i0, 1u, __ATOMIC_RELAXED, __HIP_MEMORY_SCOPE_WORKGROUP); Lb[list_off(i0) + pos] = (bf16)(t | (0 << 14)); }
    if (nv > 1) { const unsigned pos = base[i1] + __hip_atomic_fetch_add(cur + i1, 1u, __ATOMIC_RELAXED, __HIP_MEMORY_SCOPE_WORKGROUP); Lb[list_off(i1) + pos] = (bf16)(t | (1 << 14)); }
    if (nv > 2) { const unsigned pos = base[i2] + __hip_atomic_fetch_add(cur + i2, 1u, __ATOMIC_RELAXED, __HIP_MEMORY_SCOPE_WORKGROUP); Lb[list_off(i2) + pos] = (bf16)(t | (2 << 14)); }
}
__device__ __forceinline__ void moba_sel_job(const bf16* X1, const bf16* X2, const bf16* LIST, bf16* PO, float* PL, int bh, int j, int chunk, int cnt, float kmax2, LAS char* vl, int lane) {
    const int b = bh >> 3, h = bh & 7, r32 = lane & 31, hi = lane >> 5;
    const int ei = 32 * chunk + r32; const bool vq = ei < cnt;
    const unsigned e = LIST[(size_t)bh * LIST_PER_BH + list_off(j) + (vq ? ei : 32 * chunk)];
    const int t = e & 0x3fff, slot = e >> 14;
    const size_t row = (size_t)(b * SEQ + t);
    bf16x8 qf[4]; const float shift = at_load_q(X1 + row * KMRG + h * 64, hi, kmax2, qf);
    f32x16 o0, o1; float l; AT_ZERO(o0, o1, l);
    const bf16* Kb = X2 + (size_t)b * SEQ * 2048 + h * 64;
    at_run<0>(qf, shift, Kb, Kb + 512, 256 * j, 1, 0, 8, 0, 0, vl, lane, o0, o1, l);
    l += __shfl_xor(l, 32);
    if (vq) { at_store_bf16(PO + ((row * 8 + h) * 3 + slot) * 64, hi, o0, o1, 1.0f); if (hi == 0) PL[(row * 8 + h) * 3 + slot] = l; }
}
__device__ __forceinline__ void moba_own_job(bf16* X1, const bf16* X2, const bf16* PO, const float* PL, int job, float kmax2, LAS char* vl, int lane) {
    const int bh = job >> 9, n = (job >> 3) & 63, i = job & 7, b = bh >> 3, h = bh & 7, r32 = lane & 31, hi = lane >> 5;
    const int t = 256 * n + 32 * i + r32; const size_t row = (size_t)(b * SEQ + t);
    bf16* qrow = X1 + row * KMRG + h * 64;
    bf16x8 qf[4]; const float shift = at_load_q(qrow, hi, kmax2, qf);
    f32x16 o0, o1; float l; AT_ZERO(o0, o1, l);
    const bf16* Kb = X2 + (size_t)b * SEQ * 2048 + h * 64;
    at_run<2>(qf, shift, Kb, Kb + 512, 256 * n, 1, 0, i + 1, 0, 32 * i + r32, vl, lane, o0, o1, l);
    l += __shfl_xor(l, 32);
    const int nv = n < 3 ? n : 3;
    for (int s = 0; s < nv; ++s) { at_add_bf16<false>(PO + ((row * 8 + h) * 3 + s) * 64, hi, o0, o1); l += PL[(row * 8 + h) * 3 + s]; }
    at_store_bf16(qrow, hi, o0, o1, 1.0f / l);
}
__device__ __forceinline__ void dil_x_job(const bf16* X1, const bf16* X2, bf16* DO, float* DL, int unit, float kmax2, LAS char* vl, int lane) {
    const int bh = unit >> 7, P0 = (unit & 127) * 128, b = bh >> 3, h = bh & 7, r32 = lane & 31, hi = lane >> 5;
    const bf16* Kb = X2 + (size_t)b * SEQ * 2048 + 1024 + h * 64;
    for (int qt = 0; qt < 4; ++qt) {
        const int L0 = P0 + 32 * qt; const size_t row = (size_t)(b * SEQ + L0 + r32);
        bf16x8 qf[4]; const float shift = at_load_q(X1 + row * KMRG + 512 + h * 64, hi, kmax2, qf);
        f32x16 o0, o1; float l; AT_ZERO(o0, o1, l);
        const int klo = r32 > 128 - L0 ? r32 : 128 - L0, ktlo = L0 >= 128 ? 0 : (128 - L0) >> 5;
        at_run<1>(qf, shift, Kb, Kb + 512, L0 - 128, 1, ktlo, 5, klo, 128 + r32, vl, lane, o0, o1, l);
        l += __shfl_xor(l, 32);
        at_store_bf16(DO + row * 512 + h * 64, hi, o0, o1, 1.0f); if (hi == 0) DL[row * 8 + h] = l;
    }
    asm volatile("s_waitcnt vmcnt(0)" ::: "memory");
    for (int rr = 0; rr < 4; ++rr) {
        const int L0 = P0 >> 2; const size_t row = (size_t)(b * SEQ + P0 + rr + 4 * r32);
        bf16x8 qf[4]; const float shift = at_load_q(X1 + row * KMRG + 512 + h * 64, hi, kmax2, qf);
        f32x16 o0, o1; float l; AT_ZERO(o0, o1, l);
        const int klo = r32 > 128 - L0 ? r32 : 128 - L0, ktlo = L0 >= 128 ? 0 : (128 - L0) >> 5;
        at_run<1>(qf, shift, Kb, Kb + 512, rr + 4 * (L0 - 128), 4, ktlo, 5, klo, 128 + r32, vl, lane, o0, o1, l);
        l += __shfl_xor(l, 32);
        at_add_bf16<true>(DO + row * 512 + h * 64, hi, o0, o1);
        at_store_bf16(DO + row * 512 + h * 64, hi, o0, o1, 1.0f);
        if (hi == 0) DL[row * 8 + h] = l + __hip_atomic_load((const GAS float*)(DL + row * 8 + h), RLX_AGENT);
    }
}
__device__ __forceinline__ void dil_y_job(bf16* X1, const bf16* X2, const bf16* DO, const float* DL, int job, float kmax2, LAS char* vl, int lane) {
    const int bh = job >> 9, P0 = ((job >> 4) & 31) * 512, rr = job & 15, b = bh >> 3, h = bh & 7, r32 = lane & 31, hi = lane >> 5;
    const bf16* Kb = X2 + (size_t)b * SEQ * 2048 + 1024 + h * 64;
    const int L0 = P0 >> 4; const size_t row = (size_t)(b * SEQ + P0 + rr + 16 * r32);
    bf16* qrow = X1 + row * KMRG + 512 + h * 64;
    bf16x8 qf[4]; const float shift = at_load_q(qrow, hi, kmax2, qf);
    f32x16 o0, o1; float l; AT_ZERO(o0, o1, l);
    const int klo = r32 > 128 - L0 ? r32 : 128 - L0, ktlo = L0 >= 128 ? 0 : (128 - L0) >> 5;
    at_run<1>(qf, shift, Kb, Kb + 512, rr + 16 * (L0 - 128), 16, ktlo, 5, klo, 128 + r32, vl, lane, o0, o1, l);
    l += __shfl_xor(l, 32);
    at_add_bf16<false>(DO + row * 512 + h * 64, hi, o0, o1); l += DL[row * 8 + h];
    at_store_bf16(qrow, hi, o0, o1, 1.0f / l);
}

constexpr int PH_PER_LAYER = 11, NPH = 1 + DEPTH * PH_PER_LAYER;
struct Args { const float* in[14]; float* out; unsigned char* ws; int ph_lo, ph_hi; };
__global__ void __launch_bounds__(NWAVES * 64, 2) fwd(Args args) {
    extern __shared__ __attribute__((aligned(16))) unsigned char lds_raw[];
    LAS unsigned char* lds = (LAS unsigned char*)lds_raw;
    const int tid = threadIdx.x;
    const int G = gridDim.x, NGW = G * NWAVES, NTH = G * NWAVES * 64;
#define CTL ((gu32*)(wsb + WS_CTL))
    unsigned char* wsb = args.ws;
    volatile LAS unsigned* MISC = (volatile LAS unsigned*)(lds + MISC_OFF);
    for (int u = tid; u < (LDS_BYTES - LDSCTL_OFF) / 4; u += NWAVES * 64) ((LAS unsigned*)(lds + LDSCTL_OFF))[u] = 0u;
    __syncthreads();
#if MK_ONE_LAUNCH
    XcdBarrier bar = xcd_barrier_post((unsigned*)(CTL + CW_BAR), MISC + 8);
#define SEAM(p) do { if ((p) + 1 < hi) xcd_barrier(bar); } while (0)
#else
#define SEAM(p) do { } while (0)
#endif
    const int lo = args.ph_lo, hi = args.ph_hi;
#define IN(k) (lo <= (k) && (k) < hi)
#define PHB() int tidp = threadIdx.x; asm volatile("" : "+v"(tidp)); const int lane = tidp & 63, wave = __builtin_amdgcn_readfirstlane(tidp >> 6); const int gw = blockIdx.x * NWAVES + wave, gtid = blockIdx.x * (NWAVES * 64) + tidp; unsigned char* wsb = args.ws; asm volatile("" : "+s"(wsb)); (void)lane; (void)wave; (void)gw; (void)gtid;
#define X1 ((bf16*)(wsb + WS_X1))
#define X2 ((bf16*)(wsb + WS_X2))
#define GT (wsb + WS_G)
#define HB ((bf16*)(wsb + WS_HB))
#define UC ((bf16*)(wsb + WS_UC))
#define KBAR ((float*)(wsb + WS_KBAR))
#define MB ((bf16*)(wsb + WS_MB))
#define YB ((bf16*)(wsb + WS_Y))
#define HH ((bf16*)(wsb + WS_H))
#define Y2 ((bf16*)(wsb + WS_Y2))
#define WSP(off) (wsb + (off))

    if (IN(0)) { PHB();
        convert_layer(args.in, wsb, 0, lds, wave, lane, gw, NGW, gtid, NTH);
        for (int m = gw; m < M; m += NGW) row_norm_bf16(args.in[0] + (size_t)m * D, args.in[8], HB + (size_t)m * D, lane);
        SEAM(0);
    }
    for (int l = 0; l < DEPTH; ++l) {
        const int pb = 1 + l * PH_PER_LAYER;
        if (IN(pb + 0)) { PHB();
            pg8::Gemm g{HB, (const bf16*)WSP(WS_WIN), M, NIN, D}; pg8::StaticOrder S; S.init(M, NIN, G, (int)blockIdx.x);
            pg8::EpiIn E{X1, UC, X2, GT};
            pg8::gemm_phase<pg8::EpiIn, pg8::StaticOrder, PG8_ALIGN, PG8_SP2>(lds + RING_OFF, g, S, E);
            SEAM(pb + 0);
        }
        if (IN(pb + 1)) { PHB();
            for (int job = gw; job < 2048; job += NGW) kstat_job(X2, KBAR, CTL + CW_KMAX + l * 32, job, lane);
            pool_items(UC, X1, gtid, NTH);
            SEAM(pb + 1);
        }
#if ATTN_NAIVE
        if (IN(pb + 2)) { PHB();
            for (int job = gw; job < M * NH; job += NGW) { const int tg = job >> 3, h = job & 7; nv_moba(X1, X2, KBAR, tg >> 14, tg & (SEQ - 1), h, lane); }
            for (int job = gw; job < M * NH; job += NGW) { const int tg = job >> 3, h = job & 7; nv_dil(X1, X2, tg >> 14, tg & (SEQ - 1), h, lane); }
            SEAM(pb + 2);
        }
        if (IN(pb + 3)) { SEAM(pb + 3); }
        if (IN(pb + 4)) { SEAM(pb + 4); }
#else
        if (IN(pb + 2)) { PHB();
            for (int job = blockIdx.x; job < 512; job += G) moba_gate_job(X1, KBAR, CTL + CW_GCNT + l * 1024, (bf16*)(wsb + WS_LIST), job, lds, tidp);
            SEAM(pb + 2);
        }
        if (IN(pb + 3)) { PHB();
            LAS unsigned* pref = (LAS unsigned*)(lds + PREF_OFF); LAS unsigned* wtot = pref + 1032;
            gu32* gcnt = CTL + CW_GCNT + l * 1024;
            { const unsigned c0 = __hip_atomic_load(gcnt + 2 * tidp, RLX_AGENT), c1 = __hip_atomic_load(gcnt + 2 * tidp + 1, RLX_AGENT);
              const unsigned a = (c0 + 31u) >> 5, b2 = (c1 + 31u) >> 5; unsigned sc = a + b2;
#pragma unroll
              for (int o = 1; o < 64; o <<= 1) { const unsigned v = __shfl_up(sc, o); if (lane >= o) sc += v; }
              if (lane == 63) wtot[wave] = sc;
              __syncthreads();
              unsigned woff = 0; for (int w = 0; w < wave; ++w) woff += wtot[w];
              const unsigned ex = woff + sc - (a + b2);
              pref[2 * tidp] = ex; pref[2 * tidp + 1] = ex + a; if (tidp == NWAVES * 64 - 1) pref[1024] = ex + a + b2;
              __syncthreads(); }
            const unsigned T = pref[1024];
            LAS char* vl = (LAS char*)(lds + wave * VT_BYTES);
            gu32* kmx = CTL + CW_KMAX + l * 32;
            for (int u = gw; u < 2048; u += NGW)
                dil_x_job(X1, X2, (bf16*)(wsb + WS_DO), (float*)(wsb + WS_DL), u, __builtin_bit_cast(float, __hip_atomic_load(kmx + 16 + (u >> 7), RLX_AGENT)), vl, lane);
            for (unsigned it = 0;; ++it) {
                const unsigned job = (it * (unsigned)G + blockIdx.x) * NWAVES + wave; if (job >= T) break;
                int lo_ = 0, hi_ = 1024; while (hi_ - lo_ > 1) { const int mid = (lo_ + hi_) >> 1; if (pref[mid] <= job) lo_ = mid; else hi_ = mid; }
                const int bh = lo_ >> 6, j = lo_ & 63, chunk = (int)(job - pref[lo_]);
                moba_sel_job(X1, X2, (const bf16*)(wsb + WS_LIST), (bf16*)(wsb + WS_PO), (float*)(wsb + WS_PL), bh, j, chunk, (int)__hip_atomic_load(gcnt + lo_, RLX_AGENT),
                             __builtin_bit_cast(float, __hip_atomic_load(kmx + bh, RLX_AGENT)), vl, lane);
            }
            SEAM(pb + 3);
        }
        if (IN(pb + 4)) { PHB();
            LAS char* vl = (LAS char*)(lds + wave * VT_BYTES);
            gu32* kmx = CTL + CW_KMAX + l * 32;
            for (int job = gw; job < 8192; job += NGW) {
                moba_own_job(X1, X2, (const bf16*)(wsb + WS_PO), (const float*)(wsb + WS_PL), job, __builtin_bit_cast(float, __hip_atomic_load(kmx + (job >> 9), RLX_AGENT)), vl, lane);
                dil_y_job(X1, X2, (const bf16*)(wsb + WS_DO), (const float*)(wsb + WS_DL), job, __builtin_bit_cast(float, __hip_atomic_load(kmx + 16 + (job >> 9), RLX_AGENT)), vl, lane);
            }
            SEAM(pb + 4);
        }
#endif
        if (IN(pb + 5)) { PHB();
            pg8::Gemm g{X1, (const bf16*)WSP(WS_WBR), M, D, KMRG}; pg8::StaticOrder S; S.init(M, D, G, (int)blockIdx.x);
            pg8::EpiMerge E{GT, MB};
            pg8::gemm_phase<pg8::EpiMerge, pg8::StaticOrder, PG8_ALIGN, PG8_SP2>(lds + RING_OFF, g, S, E);
            SEAM(pb + 5);
        }
        if (IN(pb + 6)) { PHB();
            pg8::Gemm g{MB, (const bf16*)WSP(WS_WO), M, D, D}; pg8::StaticOrder S; S.init(M, D, G, (int)blockIdx.x);
            pg8::EpiPlain<0> E{YB, D};
            pg8::gemm_phase<pg8::EpiPlain<0>, pg8::StaticOrder, PG8_ALIGN, PG8_SP2>(lds + RING_OFF, g, S, E);
            SEAM(pb + 6);
        }
        if (IN(pb + 7)) { PHB();
            const float* xi = l == 0 ? args.in[0] : (const float*)args.out;
            for (int m = gw; m < M; m += NGW) row_post(YB + (size_t)m * D, xi + (size_t)m * D, args.out + (size_t)m * D, args.in[9] + l * D, HB + (size_t)m * D, args.in[10] + l * D, lane);
            SEAM(pb + 7);
        }
        if (IN(pb + 8)) { PHB();
            pg8::Gemm g{HB, (const bf16*)WSP(WS_W1), M, FF, D}; pg8::StaticOrder S; S.init(M, FF, G, (int)blockIdx.x);
            pg8::EpiPlain<1> E{HH, FF};
            pg8::gemm_phase<pg8::EpiPlain<1>, pg8::StaticOrder, PG8_ALIGN, PG8_SP2>(lds + RING_OFF, g, S, E);
            SEAM(pb + 8);
        }
        if (IN(pb + 9)) { PHB();
            pg8::Gemm g{HH, (const bf16*)WSP(WS_W2), M, D, FF}; pg8::StaticOrder S; S.init(M, D, G, (int)blockIdx.x);
            pg8::EpiPlain<0> E{Y2, D};
            pg8::gemm_phase<pg8::EpiPlain<0>, pg8::StaticOrder, PG8_ALIGN, PG8_SP2>(lds + RING_OFF, g, S, E);
            SEAM(pb + 9);
        }
        if (IN(pb + 10)) { PHB();
            const bool more = (l + 1 < DEPTH);
            for (int m = gw; m < M; m += NGW) row_post(Y2 + (size_t)m * D, args.out + (size_t)m * D, args.out + (size_t)m * D, args.in[11] + l * D, more ? HB + (size_t)m * D : (bf16*)nullptr, args.in[8] + (l + 1 < DEPTH ? l + 1 : l) * D, lane);
            if (more) convert_layer(args.in, wsb, l + 1, lds, wave, lane, gw, NGW, gtid, NTH);
            SEAM(pb + 10);
        }
    }
#undef IN
#undef SEAM
}

extern "C" void kernel_launch(void* const* d_in, const int* in_sizes, int n_in, void* d_out, int out_size, void* d_ws, size_t ws_size, hipStream_t stream) {
    static int grid = 0;
    if (grid == 0) {
        if (n_in != 14 || in_sizes[0] != M * D || out_size != M * D || ws_size < WS_END) { fprintf(stderr, "kernel_launch: unexpected shapes / workspace (n_in %d, in0 %d, out %d, ws %zu); nothing launched\n", n_in, n_in > 0 ? in_sizes[0] : -1, out_size, ws_size); grid = -1; return; }
        int dev = 0, cus = 0, per_cu = 0;
        if (hipGetDevice(&dev) != hipSuccess || hipDeviceGetAttribute(&cus, hipDeviceAttributeMultiprocessorCount, dev) != hipSuccess) { grid = -1; return; }
        if (hipFuncSetAttribute((const void*)fwd, hipFuncAttributeMaxDynamicSharedMemorySize, LDS_BYTES) != hipSuccess) { fprintf(stderr, "kernel_launch: hipFuncSetAttribute failed\n"); grid = -1; return; }
        if (hipOccupancyMaxActiveBlocksPerMultiprocessor(&per_cu, (const void*)fwd, NWAVES * 64, LDS_BYTES) != hipSuccess || per_cu < 1) fprintf(stderr, "kernel_launch: occupancy query reports %d workgroups per CU\n", per_cu);
        (void)hipGetLastError();
        grid = cus;
    }
    if (grid < 0) return;
    if (hipMemsetAsync((char*)d_ws + WS_CTL, 0, CTL_ZERO_BYTES, stream) != hipSuccess) return;
    Args a{};
    for (int i = 0; i < 14; ++i) a.in[i] = (const float*)d_in[i];
    a.out = (float*)d_out; a.ws = (unsigned char*)d_ws;
#if MK_ONE_LAUNCH
    a.ph_lo = 0; a.ph_hi = NPH;
    hipLaunchKernelGGL(fwd, dim3(grid), dim3(NWAVES * 64), LDS_BYTES, stream, a);
#else
    for (int p = 0; p < NPH; ++p) { a.ph_lo = p; a.ph_hi = p + 1; hipLaunchKernelGGL(fwd, dim3(grid), dim3(NWAVES * 64), LDS_BYTES, stream, a); }
#endif
}
```

```cpp
#include <hip/hip_runtime.h>
#include <cstdio>
#include <cstdint>
#include <cmath>
namespace pg8 {
#define PG8_LAS __attribute__((address_space(3)))
typedef unsigned short bf16_t;
typedef short bf16x8 __attribute__((ext_vector_type(8)));
typedef float f32x4 __attribute__((ext_vector_type(4)));
typedef unsigned u32x4 __attribute__((ext_vector_type(4)));
constexpr int BM = 256, BK = 64, HALF = 128, HTB = HALF * BK * 2  , STAGE_BYTES = 8 * HTB, NXCD = 8, WGM = 8;

__host__ __device__ __forceinline__ int lds_byte(int r, int c) { const int st = (r >> 4) * 2 + (c >> 5), rr = r & 15, cc = c & 31, ob = rr * 64 + cc * 2; return st * 1024 + (ob ^ (((ob >> 9) & 1) << 5)); }
__host__ __device__ __forceinline__ void stage_rc(int b, int& R, int& C) { const int st = b / 1024, sb = b % 1024, swz = sb ^ (((sb >> 9) & 1) << 5); R = (st >> 1) * 16 + swz / 64; C = (st & 1) * 32 + (swz % 64) / 2; }
__host__ __device__ __forceinline__ int perm32(int rho) { const int n = rho >> 4, i = rho & 15; return 8 * (i >> 2) + 4 * n + (i & 3); }

struct Unit { int pm, pn; };
struct Gemm { const bf16_t* A; const bf16_t* Bt; int M, N, K; };

struct StaticOrder {
    int nM, nN, nwg, G, c;
    __host__ __device__ void init(int M, int N, int G_, int c_) { nM = M / BM; nN = N / BM; nwg = nM * nN; G = G_; c = c_; }
    __host__ __device__ bool next(int i, Unit& u) const {
        const long L = (long)i * G + c; if (L >= nwg) return false;
        int wgid = (int)L; { const int q = nwg / NXCD, r = nwg % NXCD, xcd = wgid % NXCD, off = wgid / NXCD; wgid = (xcd < r ? xcd * (q + 1) : r * (q + 1) + (xcd - r) * q) + off; }
        const int nig = WGM * nN, gid = wgid / nig, fm = gid * WGM, gsz = (nM - fm) < WGM ? (nM - fm) : WGM;
        u.pm = fm + ((wgid % nig) % gsz); u.pn = (wgid % nig) / gsz; return true;
    }
    __device__ __forceinline__ void a_ready(const Unit&) const {}
    __device__ __forceinline__ void done(const Unit&) const {}
};

__device__ __forceinline__ unsigned cvt_pk_bf16(float lo, float hi) { unsigned r; asm volatile("v_cvt_pk_bf16_f32 %0, %1, %2" : "=v"(r) : "v"(lo), "v"(hi)); return r; }
typedef float f32x2 __attribute__((ext_vector_type(2)));
typedef unsigned u32x2 __attribute__((ext_vector_type(2)));
constexpr float kC2 = 0.125f * 1.4426950408889634f;

__device__ __forceinline__ unsigned sig_u8(float z) {
    const float g = __builtin_amdgcn_rcpf(1.0f + __builtin_amdgcn_exp2f(-1.4426950408889634f * z));
    float q = __builtin_rintf(g * 255.0f); q = q < 1.0f ? 1.0f : (q > 255.0f ? 255.0f : q);
    return (unsigned)q;
}
struct EpiIn {
    static constexpr bool PERM = true, AFTER_DRAIN = false, HAS_MID = false;
    bf16_t* X1; bf16_t* UC; bf16_t* X2; unsigned char* G;
    __device__ __forceinline__ void mid(f32x4 (&)[2][2][4][2], const Unit&, int, int, int, int, int) const {}
    __device__ __forceinline__ void operator()(const f32x4 (&acc)[2][2][4][2], const Unit& u, int wr, int wc, int fr, int fq) const {
        const int row0 = u.pm * BM + wr * 64 + fr, pn = u.pn;
        if (pn < 14) {
            bf16_t* base; int ldc, colt; float sc = 1.0f;
            if (pn < 4) { base = X1; ldc = 1536; colt = pn * BM; sc = kC2; }
            else if (pn < 6) { base = UC; ldc = 512; colt = (pn - 4) * BM; }
            else { base = X2; ldc = 2048; colt = (pn - 6) * BM; }
            const int col0 = colt + wc * 32 + 8 * fq;
#pragma unroll
            for (int ai = 0; ai < 2; ++ai)
#pragma unroll
                for (int m = 0; m < 4; ++m) { bf16_t* rowp = base + (size_t)(row0 + ai * HALF + m * 16) * ldc + col0;
#pragma unroll
                    for (int bj = 0; bj < 2; ++bj) { const f32x4 v0 = acc[ai][bj][m][0] * sc, v1 = acc[ai][bj][m][1] * sc;
                        u32x4 w; w.x = cvt_pk_bf16(v0[0], v0[1]); w.y = cvt_pk_bf16(v0[2], v0[3]); w.z = cvt_pk_bf16(v1[0], v1[1]); w.w = cvt_pk_bf16(v1[2], v1[3]);
                        *(u32x4*)(rowp + bj * HALF) = w; } }
        } else {
            const int col0 = (pn - 14) * BM + wc * 32 + 8 * fq;
#pragma unroll
            for (int ai = 0; ai < 2; ++ai)
#pragma unroll
                for (int m = 0; m < 4; ++m) { unsigned char* rowp = G + (size_t)(row0 + ai * HALF + m * 16) * 3072 + col0;
#pragma unroll
                    for (int bj = 0; bj < 2; ++bj) { const f32x4 v0 = acc[ai][bj][m][0], v1 = acc[ai][bj][m][1];
                        u32x2 w; w.x = sig_u8(v0[0]) | (sig_u8(v0[1]) << 8) | (sig_u8(v0[2]) << 16) | (sig_u8(v0[3]) << 24);
                        w.y = sig_u8(v1[0]) | (sig_u8(v1[1]) << 8) | (sig_u8(v1[2]) << 16) | (sig_u8(v1[3]) << 24);
                        *(u32x2*)(rowp + bj * HALF) = w; } }
        }
    }
};
struct EpiMerge {
    static constexpr bool PERM = true, AFTER_DRAIN = false, HAS_MID = true;
    const unsigned char* G; bf16_t* O;
    __device__ __forceinline__ void mid(f32x4 (&acc)[2][2][4][2], const Unit& u, int seg, int wr, int wc, int fr, int fq) const {
        int row0 = u.pm * BM + wr * 64 + fr, col0 = u.pn * BM + wc * 32 + 8 * fq;
        asm volatile("" : "+v"(row0), "+v"(col0));
#pragma unroll
        for (int ai = 0; ai < 2; ++ai)
#pragma unroll
            for (int m = 0; m < 4; ++m) { const unsigned char* rowp = G + (size_t)(row0 + ai * HALF + m * 16) * 3072 + col0;
#pragma unroll
                for (int bj = 0; bj < 2; ++bj) {
                    const u32x2 ga = *(const u32x2*)(rowp + (seg - 1) * 1024 + bj * HALF), gb = *(const u32x2*)(rowp + seg * 1024 + bj * HALF);
                    f32x4 r0, r1;
#pragma unroll
                    for (int j = 0; j < 4; ++j) { r0[j] = (float)((ga.x >> (8 * j)) & 255u) * __builtin_amdgcn_rcpf((float)((gb.x >> (8 * j)) & 255u));
                                                  r1[j] = (float)((ga.y >> (8 * j)) & 255u) * __builtin_amdgcn_rcpf((float)((gb.y >> (8 * j)) & 255u)); }
                    acc[ai][bj][m][0] *= r0; acc[ai][bj][m][1] *= r1; }
                asm volatile("" ::: "memory"); }
    }
    __device__ __forceinline__ void operator()(const f32x4 (&acc)[2][2][4][2], const Unit& u, int wr, int wc, int fr, int fq) const {
        const int row0 = u.pm * BM + wr * 64 + fr, col0 = u.pn * BM + wc * 32 + 8 * fq;
#pragma unroll
        for (int ai = 0; ai < 2; ++ai)
#pragma unroll
            for (int m = 0; m < 4; ++m) { const size_t r = (size_t)(row0 + ai * HALF + m * 16);
#pragma unroll
                for (int bj = 0; bj < 2; ++bj) {
                    const u32x2 gc = *(const u32x2*)(G + r * 3072 + 2048 + col0 + bj * HALF);
                    f32x4 v0 = acc[ai][bj][m][0], v1 = acc[ai][bj][m][1];
#pragma unroll
                    for (int j = 0; j < 4; ++j) { v0[j] *= (float)((gc.x >> (8 * j)) & 255u) * (1.0f / 255.0f); v1[j] *= (float)((gc.y >> (8 * j)) & 255u) * (1.0f / 255.0f); }
                    u32x4 w; w.x = cvt_pk_bf16(v0[0], v0[1]); w.y = cvt_pk_bf16(v0[2], v0[3]); w.z = cvt_pk_bf16(v1[0], v1[1]); w.w = cvt_pk_bf16(v1[2], v1[3]);
                    *(u32x4*)(O + r * 1024 + col0 + bj * HALF) = w; }
                asm volatile("" ::: "memory"); }
    }
};
template <int ACT> struct EpiPlain {
    static constexpr bool PERM = true, AFTER_DRAIN = false, HAS_MID = false;
    bf16_t* O; int ldc;
    __device__ __forceinline__ void mid(f32x4 (&)[2][2][4][2], const Unit&, int, int, int, int, int) const {}
    __device__ __forceinline__ void operator()(const f32x4 (&acc)[2][2][4][2], const Unit& u, int wr, int wc, int fr, int fq) const {
        const int row0 = u.pm * BM + wr * 64 + fr, col0 = u.pn * BM + wc * 32 + 8 * fq;
#pragma unroll
        for (int ai = 0; ai < 2; ++ai)
#pragma unroll
            for (int m = 0; m < 4; ++m) { bf16_t* rowp = O + (size_t)(row0 + ai * HALF + m * 16) * ldc + col0;
#pragma unroll
                for (int bj = 0; bj < 2; ++bj) { f32x4 v0 = acc[ai][bj][m][0], v1 = acc[ai][bj][m][1];
                    if (ACT == 1) {
#pragma unroll
                        for (int j = 0; j < 4; ++j) { const float a = v0[j] > 0.f ? v0[j] : 0.f, b = v1[j] > 0.f ? v1[j] : 0.f; v0[j] = a * a; v1[j] = b * b; } }
                    u32x4 w; w.x = cvt_pk_bf16(v0[0], v0[1]); w.y = cvt_pk_bf16(v0[2], v0[3]); w.z = cvt_pk_bf16(v1[0], v1[1]); w.w = cvt_pk_bf16(v1[2], v1[3]);
                    *(u32x4*)(rowp + bj * HALF) = w; } }
    }
};

template <class Epi, class Sched, bool ALIGN_EPI = false, bool SP2 = false>
__device__ __forceinline__ void gemm_phase(PG8_LAS unsigned char* lds, const Gemm g, const Sched& S, const Epi& E) {
    int tid_ = threadIdx.x; asm volatile("" : "+v"(tid_));
    const int tid = tid_, wid = __builtin_amdgcn_readfirstlane(tid >> 6), lane = tid & 63, wr = wid >> 2, wc = wid & 3, fr = lane & 15, fq = lane >> 4;
    const int K = g.K, nt = K / BK;
    unsigned voffA[2], voffB[2];
#pragma unroll
    for (int i = 0; i < 2; ++i) { int R, C; stage_rc(tid * 16 + i * 8192, R, C); const int Rb = Epi::PERM ? ((R & ~31) + perm32(R & 31)) : R;
        voffA[i] = (unsigned)(R * K + C) * 2u; voffB[i] = (unsigned)(Rb * K + C) * 2u; }
    const size_t kstep = (size_t)(BK * 2);
    const size_t hstep = (size_t)HALF * K * 2;
    const size_t tstep = 2 * hstep;
    const unsigned ldsw = (unsigned)wid * 1024u;
    const int aoff = lds_byte(wr * 64 + fr, fq * 8), boff = lds_byte(wc * 32 + fr, fq * 8);
#define PG8_SA(b, h) (((b) * 2 + (h)) * HTB)
#define PG8_SB(b, h) ((4 + (b) * 2 + (h)) * HTB)
#define PG8_STAGE(bufoff, gbase, voff) do { _Pragma("unroll") for (int _i = 0; _i < 2; ++_i) \
        __builtin_amdgcn_global_load_lds((const unsigned*)((const char*)(gbase) + (voff)[_i]), (PG8_LAS unsigned*)(lds + (bufoff) + ldsw + _i * 8192), 16, 0, 0); } while (0)
#define PG8_LDA(dst, b, h) do { _Pragma("unroll") for (int m = 0; m < 4; ++m) _Pragma("unroll") for (int k = 0; k < 2; ++k) dst[m][k] = *(const PG8_LAS bf16x8*)(lds + PG8_SA(b, h) + aoff + m * 2048 + k * 1024); } while (0)
#define PG8_LDB(dst, b, h) do { _Pragma("unroll") for (int n = 0; n < 2; ++n) _Pragma("unroll") for (int k = 0; k < 2; ++k) dst[n][k] = *(const PG8_LAS bf16x8*)(lds + PG8_SB(b, h) + boff + n * 2048 + k * 1024); } while (0)
#define PG8_MMA(ai, bj, At, Bt) do { __builtin_amdgcn_s_setprio(1); _Pragma("unroll") for (int m = 0; m < 4; ++m) _Pragma("unroll") for (int n = 0; n < 2; ++n) _Pragma("unroll") for (int k = 0; k < 2; ++k) \
        acc[ai][bj][m][n] = __builtin_amdgcn_mfma_f32_16x16x32_bf16(Bt[n][k], At[m][k], acc[ai][bj][m][n], 0, 0, 0); __builtin_amdgcn_s_setprio(0); } while (0)
#define PG8_WAIT_V(n) asm volatile("s_waitcnt vmcnt(" #n ")" ::: "memory")
#define PG8_WAIT_L(n) asm volatile("s_waitcnt lgkmcnt(" #n ")" ::: "memory")
#define PG8_BAR __builtin_amdgcn_s_barrier()
#define PG8_SCHED __builtin_amdgcn_sched_barrier(0)
    Unit cur, nxt; int ui = 0;
    if (!S.next(0, cur)) return;
    f32x4 acc[2][2][4][2];
#pragma unroll
    for (int a = 0; a < 2; ++a)
#pragma unroll
        for (int b = 0; b < 2; ++b)
#pragma unroll
            for (int m = 0; m < 4; ++m)
#pragma unroll
                for (int n = 0; n < 2; ++n) acc[a][b][m][n] = (f32x4){0.f, 0.f, 0.f, 0.f};
    bf16x8 At[4][2], B0[2][2], B1[2][2];
    const char* cA = (const char*)g.A + (size_t)cur.pm * tstep; const char* cB = (const char*)g.Bt + (size_t)cur.pn * tstep;
    S.a_ready(cur);
    if constexpr (SP2) {
        PG8_STAGE(PG8_SB(0, 0), cB, voffB); PG8_STAGE(PG8_SB(0, 1), cB + hstep, voffB); PG8_STAGE(PG8_SA(0, 0), cA, voffA); PG8_STAGE(PG8_SA(0, 1), cA + hstep, voffA);
        if (wr == 1) PG8_BAR;
        PG8_WAIT_V(2); PG8_BAR;
        PG8_STAGE(PG8_SB(1, 0), cB + kstep, voffB); PG8_STAGE(PG8_SA(1, 0), cA + kstep, voffA); PG8_STAGE(PG8_SB(1, 1), cB + hstep + kstep, voffB);
        PG8_WAIT_V(6); PG8_BAR;
    } else {
        PG8_STAGE(PG8_SB(0, 0), cB, voffB); PG8_STAGE(PG8_SA(0, 0), cA, voffA); PG8_STAGE(PG8_SB(0, 1), cB + hstep, voffB); PG8_STAGE(PG8_SA(0, 1), cA + hstep, voffA);
        if (wr == 1) PG8_BAR;
        PG8_WAIT_V(4); PG8_BAR;
        PG8_STAGE(PG8_SB(1, 0), cB + kstep, voffB); PG8_STAGE(PG8_SA(1, 0), cA + kstep, voffA); PG8_STAGE(PG8_SB(1, 1), cB + hstep + kstep, voffB);
        PG8_WAIT_V(6); PG8_BAR;
    }
    for (;;) {
        const bool has_next = S.next(ui + 1, nxt);
        const char* nA = has_next ? (const char*)g.A + (size_t)nxt.pm * tstep : cA; const char* nB = has_next ? (const char*)g.Bt + (size_t)nxt.pn * tstep : cB;
        for (int t = 0; t < nt; t += 2) {
            const bool last = (t == nt - 2);
            const char* a1 = cA + (size_t)(t + 1) * kstep;
            const char* a2 = last ? nA : cA + (size_t)(t + 2) * kstep; const char* b2 = last ? nB : cB + (size_t)(t + 2) * kstep;
            const char* a3 = a2 + kstep; const char* b3 = b2 + kstep;
            if (last && has_next) S.a_ready(nxt);
            if constexpr (SP2) {
            PG8_LDB(B0, 0, 0); PG8_LDB(B1, 0, 1); PG8_SCHED; PG8_LDA(At, 0, 0); PG8_STAGE(PG8_SA(1, 1), a1 + hstep, voffA);
            PG8_WAIT_V(8); PG8_WAIT_L(0); PG8_BAR; PG8_MMA(0, 0, At, B0); PG8_MMA(0, 1, At, B1); PG8_BAR; PG8_SCHED;
            PG8_LDA(At, 0, 1); PG8_STAGE(PG8_SB(0, 0), b2, voffB); PG8_STAGE(PG8_SB(0, 1), b2 + hstep, voffB); PG8_STAGE(PG8_SA(0, 0), a2, voffA);
            PG8_WAIT_V(8); PG8_WAIT_L(0); PG8_BAR; PG8_MMA(1, 0, At, B0); PG8_MMA(1, 1, At, B1); PG8_BAR; PG8_SCHED;
            PG8_LDB(B0, 1, 0); PG8_LDB(B1, 1, 1); PG8_SCHED; PG8_LDA(At, 1, 0); PG8_STAGE(PG8_SA(0, 1), a2 + hstep, voffA);
            PG8_WAIT_V(8); PG8_WAIT_L(0); PG8_BAR; PG8_MMA(0, 0, At, B0); PG8_MMA(0, 1, At, B1); PG8_BAR; PG8_SCHED;
            PG8_LDA(At, 1, 1); PG8_STAGE(PG8_SB(1, 0), b3, voffB); PG8_STAGE(PG8_SB(1, 1), b3 + hstep, voffB); PG8_STAGE(PG8_SA(1, 0), a3, voffA);
            PG8_WAIT_V(8); PG8_WAIT_L(0); PG8_BAR; PG8_MMA(1, 0, At, B0); PG8_MMA(1, 1, At, B1); PG8_BAR; PG8_SCHED;
            } else {
            PG8_LDB(B0, 0, 0); PG8_SCHED; PG8_LDA(At, 0, 0); PG8_STAGE(PG8_SA(1, 1), a1 + hstep, voffA);
            PG8_WAIT_L(8); PG8_BAR; PG8_WAIT_L(0); PG8_MMA(0, 0, At, B0); PG8_BAR; PG8_SCHED;
            PG8_LDB(B1, 0, 1); PG8_STAGE(PG8_SB(0, 0), b2, voffB);
            PG8_BAR; PG8_WAIT_L(0); PG8_MMA(0, 1, At, B1); PG8_BAR;
            PG8_LDA(At, 0, 1); PG8_STAGE(PG8_SA(0, 0), a2, voffA);
            PG8_BAR; PG8_WAIT_L(0); PG8_MMA(1, 0, At, B0); PG8_BAR; PG8_SCHED;
            PG8_STAGE(PG8_SB(0, 1), b2 + hstep, voffB);
            PG8_WAIT_V(6); PG8_BAR; PG8_MMA(1, 1, At, B1); PG8_BAR;
            PG8_LDB(B0, 1, 0); PG8_SCHED; PG8_LDA(At, 1, 0); PG8_STAGE(PG8_SA(0, 1), a2 + hstep, voffA);
            PG8_WAIT_L(8); PG8_BAR; PG8_WAIT_L(0); PG8_MMA(0, 0, At, B0); PG8_BAR; PG8_SCHED;
            PG8_LDB(B1, 1, 1); PG8_STAGE(PG8_SB(1, 0), b3, voffB);
            PG8_BAR; PG8_WAIT_L(0); PG8_MMA(0, 1, At, B1); PG8_BAR;
            PG8_LDA(At, 1, 1); PG8_STAGE(PG8_SA(1, 0), a3, voffA);
            PG8_BAR; PG8_WAIT_L(0); PG8_MMA(1, 0, At, B0); PG8_BAR; PG8_SCHED;
            PG8_STAGE(PG8_SB(1, 1), b3 + hstep, voffB);
            PG8_WAIT_V(6); PG8_BAR; PG8_MMA(1, 1, At, B1); PG8_BAR;
            }
            if constexpr (Epi::HAS_MID) { if (t + 2 < nt && ((t + 2) & 7) == 0) E.mid(acc, cur, (t + 2) >> 3, wr, wc, fr, fq); }
        }
        if constexpr (ALIGN_EPI) { if (wr == 0) PG8_BAR; }
        if constexpr (!Epi::AFTER_DRAIN) { E(acc, cur, wr, wc, fr, fq); S.done(cur); }
        if (!has_next) break;
#pragma unroll
        for (int a = 0; a < 2; ++a)
#pragma unroll
            for (int b = 0; b < 2; ++b)
#pragma unroll
                for (int m = 0; m < 4; ++m)
#pragma unroll
                    for (int n = 0; n < 2; ++n) acc[a][b][m][n] = (f32x4){0.f, 0.f, 0.f, 0.f};
        cur = nxt; cA = nA; cB = nB; ++ui;
        if constexpr (ALIGN_EPI) { if (wr == 1) PG8_BAR; }
    }
    PG8_WAIT_V(0);
    if constexpr (!ALIGN_EPI) { if (wr == 0) PG8_BAR; }
    PG8_BAR;
    if constexpr (Epi::AFTER_DRAIN) { E.fused(acc, cur, wr, wc, fr, fq, lds, wid, lane); S.done(cur); }
#undef PG8_SA
#undef PG8_SB
#undef PG8_STAGE
#undef PG8_LDA
#undef PG8_LDB
#undef PG8_MMA
#undef PG8_WAIT_V
#undef PG8_WAIT_L
#undef PG8_BAR
#undef PG8_SCHED
}
}
#ifndef PG8_SP2
#define PG8_SP2 true
#endif
#ifndef PG8_ALIGN
#define PG8_ALIGN true
#endif
#ifndef ATTN_NAIVE
#define ATTN_NAIVE 0
#endif
#ifndef ATTN_CHECK
#define ATTN_CHECK 0
#endif
#ifndef CHK_SEL
#define CHK_SEL 15
#endif
#ifndef REP_GEMM
#define REP_GEMM 1
#endif
#ifndef REP_X
#define REP_X 1
#endif
#ifndef REP_KP
#define REP_KP 1
#endif
#ifndef TIME_PROBE
#define TIME_PROBE 0
#endif
#ifndef TIME_A
#define TIME_A 3
#endif
#ifndef TIME_B
#define TIME_B 4
#endif
#ifndef MK_ONE_LAUNCH
#define MK_ONE_LAUNCH 1
#endif

constexpr int BATCH = 2, SEQ = 16384, D = 1024, DEPTH = 2, HD = 64, NH = 8, FF = 4096;
constexpr int M = BATCH * SEQ;
constexpr int NIN = 6656;
constexpr int KMRG = 1536;
constexpr float RMS_EPS = 1e-6f;
constexpr int NWAVES = 8;

constexpr size_t MiB = 1u << 20;
constexpr size_t WS_CTL = 0, CTL_ZERO_BYTES = 1 * MiB;
constexpr size_t WS_WIN = 1 * MiB, WS_WBR = 14 * MiB, WS_WO = 17 * MiB, WS_W1 = 19 * MiB, WS_W2 = 27 * MiB;
constexpr size_t WS_X1 = 35 * MiB;
constexpr size_t WS_X2 = 131 * MiB;
constexpr size_t WS_G = 259 * MiB;
constexpr size_t WS_HB = 355 * MiB;
constexpr size_t WS_UC = 419 * MiB;
constexpr size_t WS_PO = 355 * MiB;
constexpr size_t WS_PL = 451 * MiB;
constexpr size_t WS_DO = 454 * MiB;
constexpr size_t WS_DL = 486 * MiB;
constexpr size_t WS_LIST = 487 * MiB;
constexpr size_t WS_KBAR = 503 * MiB;
#if ATTN_CHECK
constexpr size_t WS_CHK = 504 * MiB, WS_END = 508 * MiB;
#else
constexpr size_t WS_END = 504 * MiB;
#endif
constexpr size_t WS_MB = 131 * MiB;
constexpr size_t WS_Y = 195 * MiB;
constexpr size_t WS_H = 35 * MiB;
constexpr size_t WS_Y2 = 291 * MiB;
constexpr int CW_BAR = 4096;
constexpr int CW_KMAX = 8192;
constexpr int CW_CHK = 12288;
constexpr int CW_GCNT = 16384;
constexpr int PREF_OFF = 40960;

constexpr int RING_OFF = 0, RING_BYTES = 131072;
constexpr int LDSCTL_OFF = RING_BYTES, MISC_OFF = LDSCTL_OFF + 320;
constexpr int LDS_BYTES = 147456;

#define GAS __attribute__((address_space(1)))
#define LAS __attribute__((address_space(3)))
typedef unsigned short bf16;
typedef unsigned v4u __attribute__((ext_vector_type(4)));
typedef unsigned v2u __attribute__((ext_vector_type(2)));
typedef float f32x4 __attribute__((ext_vector_type(4)));
typedef GAS unsigned gu32;
#define RLX_AGENT __ATOMIC_RELAXED, __HIP_MEMORY_SCOPE_AGENT
#define LDS_WAIT() asm volatile("s_waitcnt lgkmcnt(0)" ::: "memory")
__device__ __forceinline__ unsigned f2bf(float f) { unsigned u = __builtin_bit_cast(unsigned, f); return (u + 0x7fffu + ((u >> 16) & 1u)) >> 16; }
__device__ __forceinline__ unsigned pk2(float lo, float hi) { return f2bf(lo) | (f2bf(hi) << 16); }
__device__ __forceinline__ float bflo(unsigned w) { return __builtin_bit_cast(float, w << 16); }
__device__ __forceinline__ float bfhi(unsigned w) { return __builtin_bit_cast(float, w & 0xffff0000u); }
__device__ __forceinline__ float bf1(bf16 b) { return __builtin_bit_cast(float, ((unsigned)b) << 16); }
__device__ __forceinline__ float wave_sum(float v) {
#pragma unroll
    for (int o = 1; o < 64; o <<= 1) v += __shfl_xor(v, o);
    return v;
}
__device__ __forceinline__ float wave_max(float v) {
#pragma unroll
    for (int o = 1; o < 64; o <<= 1) v = fmaxf(v, __shfl_xor(v, o));
    return v;
}

#define XB_TMO      128
#define XB_XCNT(j)  (256  + 64 * (j))
#define XB_XSUB(j)  (1280 + 64 * (j))
#define XB_XGEN(j)  (2304 + 64 * (j))
#define XB_TOP      3328
#define XB_TOPGEN   3392
#define XCD_BAR_WORDS 3456
#define XB_SPIN_CAP (1u << 18)

__device__ __forceinline__ unsigned xb_ld(unsigned* p)              { return __hip_atomic_load(p, __ATOMIC_RELAXED, __HIP_MEMORY_SCOPE_AGENT); }
__device__ __forceinline__ unsigned xb_add(unsigned* p, unsigned v) { return __hip_atomic_fetch_add(p, v, __ATOMIC_RELAXED, __HIP_MEMORY_SCOPE_AGENT); }
__device__ __forceinline__ unsigned xb_xcc_id() { return (unsigned)__builtin_amdgcn_s_getreg((3 << 11) | 20) & 0xFu; }
#define XB_SPIN(cond, bar) do { unsigned _sp = 0; while (cond) { __builtin_amdgcn_s_sleep(1); \
    if ((++_sp & 255u) == 0u) { if (xb_ld(&(bar)[XB_TMO])) break; if (_sp > XB_SPIN_CAP) { atomicAdd(&(bar)[XB_TMO], 1u); break; } } } } while (0)

struct XcdBarrier {
    unsigned* bar; unsigned x;
    volatile LAS unsigned* st;
};

__device__ __forceinline__ XcdBarrier xcd_barrier_post(unsigned* bar, volatile LAS unsigned* st) {
    XcdBarrier b; b.bar = bar; b.x = xb_xcc_id(); b.st = st;
    if (threadIdx.x == 0) (void)xb_add(&bar[XB_XCNT(b.x)], 1u);
    return b;
}
__device__ __forceinline__ void xcd_barrier_complete(unsigned* bar, unsigned x, unsigned& nloc, unsigned& nx) {
    const unsigned G = gridDim.x * gridDim.y * gridDim.z;
    unsigned sum, cnt, mine, sp = 0u;
    for (;;) {
        sum = 0u; cnt = 0u; mine = 0u;
#pragma unroll
        for (unsigned j = 0; j < 16; ++j) { const unsigned c = xb_ld(&bar[XB_XCNT(j)]); sum += c; cnt += (c > 0u) ? 1u : 0u; mine = (j == x) ? c : mine; }
        if (sum == G) break;
        __builtin_amdgcn_s_sleep(1);
        if ((++sp & 255u) == 0u) { if (xb_ld(&bar[XB_TMO])) break; if (sp > XB_SPIN_CAP) { atomicAdd(&bar[XB_TMO], 1u); break; } }
    }
    nloc = mine > 0u ? mine : 1u; nx = cnt > 0u ? cnt : 1u;
}

__device__ __forceinline__ void xcd_barrier(const XcdBarrier& b) {
    asm volatile("s_waitcnt vmcnt(0)" ::: "memory");
    __syncthreads();
    if (threadIdx.x == 0) {
        unsigned* bar = b.bar;
        __builtin_amdgcn_s_waitcnt(0);
        unsigned nloc = b.st[0], nx = b.st[1];
        if (nloc == 0u) { xcd_barrier_complete(bar, b.x, nloc, nx); b.st[0] = nloc; b.st[1] = nx; }
        const unsigned old = xb_add(&bar[XB_XSUB(b.x)], 1u);
        const unsigned gen = old / nloc;
        if (old + 1u == (gen + 1u) * nloc) {
            __builtin_amdgcn_fence(__ATOMIC_RELEASE, "agent");
            asm volatile("s_waitcnt vmcnt(0)" ::: "memory");
            const unsigned og = xb_add(&bar[XB_TOP], 1u);
            const unsigned tg = og / nx;
            if (og + 1u == (tg + 1u) * nx) xb_add(&bar[XB_TOPGEN], 1u);
            else XB_SPIN(xb_ld(&bar[XB_TOPGEN]) == tg, bar);
            __builtin_amdgcn_fence(__ATOMIC_ACQUIRE, "agent");
            xb_add(&bar[XB_XGEN(b.x)], 1u);
            asm volatile("s_waitcnt vmcnt(0)" ::: "memory");
        } else {
            XB_SPIN(xb_ld(&bar[XB_XGEN(b.x)]) == gen, bar);
            __builtin_amdgcn_fence(__ATOMIC_ACQUIRE, "agent");
            asm volatile("s_waitcnt vmcnt(0)" ::: "memory");
        }
    }
    __syncthreads();
}

__device__ __forceinline__ void tr_item(const float* W, int ldw, int k0, int n0src, bf16* WT, int ldt, int rowdst0, int kdst0, LAS float* scr, int lane) {
#pragma unroll 8
    for (int i = 0; i < 32; ++i) { const int kk = 2 * i + (lane >> 5); scr[kk * 33 + (lane & 31)] = W[(size_t)(k0 + kk) * ldw + n0src + (lane & 31)]; }
    LDS_WAIT(); asm volatile("" ::: "memory");
    const int c = lane & 7;
#pragma unroll
    for (int j = 0; j < 4; ++j) { const int n = (lane >> 3) + 8 * j; const LAS float* s = scr + (8 * c) * 33 + n;
        v4u o; o.x = pk2(s[0 * 33], s[1 * 33]); o.y = pk2(s[2 * 33], s[3 * 33]); o.z = pk2(s[4 * 33], s[5 * 33]); o.w = pk2(s[6 * 33], s[7 * 33]);
        *(GAS v4u*)(WT + (size_t)(rowdst0 + n) * ldt + kdst0 + k0 + 8 * c) = o; }
    LDS_WAIT(); asm volatile("" ::: "memory");
}
__device__ __forceinline__ void convert_layer(const float* const* in, unsigned char* ws, int l, LAS unsigned char* lds, int wave, int lane, int gw, int NGW, int gtid, int NTH) {
    const float* Win = in[1] + (size_t)l * D * NIN; const float* Wa = in[2] + (size_t)l * 512 * D; const float* Wb = in[3] + (size_t)l * 512 * D; const float* Wc = in[4] + (size_t)l * 512 * D;
    const float* Wo = in[5] + (size_t)l * D * D; const float* Wp = in[6] + (size_t)l * 4 * 128 * 128; const float* Ps = in[7] + (size_t)l * 512;
    const float* W1 = in[12] + (size_t)l * D * FF; const float* W2 = in[13] + (size_t)l * FF * D;
    bf16* WinT = (bf16*)(ws + WS_WIN); bf16* WbrT = (bf16*)(ws + WS_WBR); bf16* WoT = (bf16*)(ws + WS_WO); bf16* W1T = (bf16*)(ws + WS_W1); bf16* W2T = (bf16*)(ws + WS_W2);
    LAS float* scr = (LAS float*)(lds + RING_OFF + wave * 16384);
    constexpr int I_IN = 16 * 208, I_BR = 8 * 32, I_O = 16 * 32, I_1 = 16 * 128, I_2 = 64 * 32, NIT = I_IN + 2 * I_BR + I_O + I_1 + I_2;
    for (int it = gw; it < NIT; it += NGW) {
        int r = it;
        if (r < I_IN) { const int kb = r / 208, nb = r % 208, n0 = 32 * nb, db = n0 >> 9;
            const int sb = db == 1 ? 3 : db == 2 ? 6 : db == 3 ? 1 : db == 4 ? 2 : db == 5 ? 4 : db == 6 ? 5 : db;
            tr_item(Win, NIN, 64 * kb, sb * 512 + (n0 & 511), WinT, D, n0, 0, scr, lane); continue; } r -= I_IN;
        if (r < I_BR) { tr_item(Wa, D, 64 * (r / 32), 32 * (r % 32), WbrT, KMRG, 32 * (r % 32), 0, scr, lane); continue; } r -= I_BR;
        if (r < I_BR) { tr_item(Wb, D, 64 * (r / 32), 32 * (r % 32), WbrT, KMRG, 32 * (r % 32), 512, scr, lane); continue; } r -= I_BR;
        if (r < I_O) { tr_item(Wo, D, 64 * (r / 32), 32 * (r % 32), WoT, D, 32 * (r % 32), 0, scr, lane); continue; } r -= I_O;
        if (r < I_1) { tr_item(W1, FF, 64 * (r / 128), 32 * (r % 128), W1T, D, 32 * (r % 128), 0, scr, lane); continue; } r -= I_1;
        tr_item(W2, D, 64 * (r / 32), 32 * (r % 32), W2T, FF, 32 * (r % 32), 0, scr, lane);
    }
    for (int i = gtid; i < 65536; i += NTH) {
        const int n = i & 1023, rest = i >> 10, g = rest >> 4, cc = rest & 15;
        float a[8];
#pragma unroll
        for (int j = 0; j < 8; ++j) a[j] = 0.f;
        const float* wp = Wp + (size_t)(g * 128 + 8 * cc) * 128;
        for (int d = 0; d < 128; ++d) { const float wsv = Wc[(size_t)(g * 128 + d) * D + n] * Ps[g * 128 + d];
#pragma unroll
            for (int j = 0; j < 8; ++j) a[j] += wp[j * 128 + d] * wsv; }
        v4u o; o.x = pk2(a[0], a[1]); o.y = pk2(a[2], a[3]); o.z = pk2(a[4], a[5]); o.w = pk2(a[6], a[7]);
        *(GAS v4u*)(WbrT + (size_t)n * KMRG + 1024 + g * 128 + 8 * cc) = o;
    }
}
__device__ __forceinline__ void row_norm_bf16(const float* xrow, const float* g, bf16* orow, int lane) {
    const GAS f32x4* xr = (const GAS f32x4*)xrow + lane; const GAS f32x4* gr = (const GAS f32x4*)g + lane;
    f32x4 v[4]; float s = 0.f;
#pragma unroll
    for (int j = 0; j < 4; ++j) { v[j] = xr[64 * j]; s += (v[j].x * v[j].x + v[j].y * v[j].y) + (v[j].z * v[j].z + v[j].w * v[j].w); }
    const float r = 1.0f / sqrtf(wave_sum(s) * (1.0f / D) + RMS_EPS);
    GAS v2u* o8 = (GAS v2u*)orow + lane;
#pragma unroll
    for (int j = 0; j < 4; ++j) { const f32x4 gg = gr[64 * j]; v2u w; w.x = pk2(v[j].x * r * gg.x, v[j].y * r * gg.y); w.y = pk2(v[j].z * r * gg.z, v[j].w * r * gg.w); o8[64 * j] = w; }
}
__device__ __forceinline__ void row_post(const bf16* yrow, const float* xin, float* xout, const float* gpost, bf16* hb, const float* gnext, int lane) {
    const GAS v2u* yr = (const GAS v2u*)yrow + lane;
    f32x4 y[4]; float s = 0.f;
#pragma unroll
    for (int j = 0; j < 4; ++j) { const v2u w = yr[64 * j]; y[j] = (f32x4){bflo(w.x), bfhi(w.x), bflo(w.y), bfhi(w.y)}; s += (y[j].x * y[j].x + y[j].y * y[j].y) + (y[j].z * y[j].z + y[j].w * y[j].w); }
    const float r = 1.0f / sqrtf(wave_sum(s) * (1.0f / D) + RMS_EPS);
    f32x4 x1[4]; float s2 = 0.f;
#pragma unroll
    for (int j = 0; j < 4; ++j) { const f32x4 xi = ((const GAS f32x4*)xin)[lane + 64 * j], gp = ((const GAS f32x4*)gpost)[lane + 64 * j];
        x1[j] = xi + y[j] * r * gp; ((GAS f32x4*)xout)[lane + 64 * j] = x1[j];
        s2 += (x1[j].x * x1[j].x + x1[j].y * x1[j].y) + (x1[j].z * x1[j].z + x1[j].w * x1[j].w); }
    if (hb) {
        const float r2 = 1.0f / sqrtf(wave_sum(s2) * (1.0f / D) + RMS_EPS);
        GAS v2u* o8 = (GAS v2u*)hb + lane;
#pragma unroll
        for (int j = 0; j < 4; ++j) { const f32x4 gn = ((const GAS f32x4*)gnext)[lane + 64 * j]; v2u w; w.x = pk2(x1[j].x * r2 * gn.x, x1[j].y * r2 * gn.y); w.y = pk2(x1[j].z * r2 * gn.z, x1[j].w * r2 * gn.w); o8[64 * j] = w; }
    }
}
__device__ __forceinline__ void kstat_job(const bf16* X2, float* kbar, gu32* kmax, int job, int lane) {
    const int mixer = job >> 10, b = (job >> 9) & 1, h = (job >> 6) & 7, j = job & 63;
    const bf16* rows = X2 + (size_t)(b * SEQ + 256 * j) * 2048 + mixer * 1024 + h * 64;
    const int piece = lane & 7, rg = lane >> 3;
    float a[8]; float mx = 0.f;
#pragma unroll
    for (int i = 0; i < 8; ++i) a[i] = 0.f;
    for (int it = 0; it < 32; ++it) {
        const v4u w = *(const GAS v4u*)(rows + (size_t)(it * 8 + rg) * 2048 + piece * 8);
        const float v0 = bflo(w.x), v1 = bfhi(w.x), v2 = bflo(w.y), v3 = bfhi(w.y), v4 = bflo(w.z), v5 = bfhi(w.z), v6 = bflo(w.w), v7 = bfhi(w.w);
        a[0] += v0; a[1] += v1; a[2] += v2; a[3] += v3; a[4] += v4; a[5] += v5; a[6] += v6; a[7] += v7;
        float ss = (v0 * v0 + v1 * v1) + (v2 * v2 + v3 * v3) + (v4 * v4 + v5 * v5) + (v6 * v6 + v7 * v7);
        ss += __shfl_xor(ss, 1); ss += __shfl_xor(ss, 2); ss += __shfl_xor(ss, 4);
        mx = fmaxf(mx, ss);
    }
#pragma unroll
    for (int i = 0; i < 8; ++i) { a[i] += __shfl_xor(a[i], 8); a[i] += __shfl_xor(a[i], 16); a[i] += __shfl_xor(a[i], 32); }
    if (mixer == 0 && lane < 8) {
        float* o = kbar + ((size_t)((b * 8 + h) * 64 + j)) * 64 + piece * 8;
#pragma unroll
        for (int i = 0; i < 8; ++i) o[i] = a[i] * (1.0f / 256.0f);
    }
    mx = wave_max(mx);
    if (lane == 0) __hip_atomic_fetch_max(kmax + mixer * 16 + b * 8 + h, __builtin_bit_cast(unsigned, mx), RLX_AGENT);
}
__device__ __forceinline__ void pool_items(const bf16* UC, bf16* X1, int gtid, int NTH) {
    for (int i = gtid; i < M * 64; i += NTH) {
        const int t = i >> 6, c0 = (i & 63) * 8, g = c0 >> 7, w = 2 << g, tp = t & (SEQ - 1), cnt = (tp + 1) < w ? (tp + 1) : w;
        float s[8], self[8];
#pragma unroll
        for (int j = 0; j < 8; ++j) s[j] = 0.f;
        for (int k = 0; k < cnt; ++k) {
            const v4u v = *(const GAS v4u*)(UC + (size_t)(t - k) * 512 + c0);
            const float f[8] = {bflo(v.x), bfhi(v.x), bflo(v.y), bfhi(v.y), bflo(v.z), bfhi(v.z), bflo(v.w), bfhi(v.w)};
#pragma unroll
            for (int j = 0; j < 8; ++j) { s[j] += f[j]; if (k == 0) self[j] = f[j]; }
        }
        const float inv = 1.0f / (float)cnt;
        v4u o; o.x = pk2(s[0] * inv - self[0], s[1] * inv - self[1]); o.y = pk2(s[2] * inv - self[2], s[3] * inv - self[3]);
        o.z = pk2(s[4] * inv - self[4], s[5] * inv - self[5]); o.w = pk2(s[6] * inv - self[6], s[7] * inv - self[7]);
        *(GAS v4u*)(X1 + (size_t)t * KMRG + 1024 + c0) = o;
    }
}


__device__ __forceinline__ void rows_post(const bf16* Y, const float* xin, float* xout, const float* gpost, bf16* HBo, const float* gnext, int gw, int NGW, int lane) {
    f32x4 gp[4], gn[4];
#pragma unroll
    for (int j = 0; j < 4; ++j) { gp[j] = ((const GAS f32x4*)gpost)[lane + 64 * j]; gn[j] = ((const GAS f32x4*)gnext)[lane + 64 * j]; }
    v2u yn[4]; f32x4 xn[4];
    int m = gw;
    if (m < M) {
#pragma unroll
        for (int j = 0; j < 4; ++j) { yn[j] = ((const GAS v2u*)(Y + (size_t)m * D))[lane + 64 * j]; xn[j] = ((const GAS f32x4*)(xin + (size_t)m * D))[lane + 64 * j]; } }
    for (; m < M; m += NGW) {
        f32x4 y[4], xi[4]; float s = 0.f;
#pragma unroll
        for (int j = 0; j < 4; ++j) { y[j] = (f32x4){bflo(yn[j].x), bfhi(yn[j].x), bflo(yn[j].y), bfhi(yn[j].y)}; xi[j] = xn[j]; s += (y[j].x * y[j].x + y[j].y * y[j].y) + (y[j].z * y[j].z + y[j].w * y[j].w); }
        const int mn = m + NGW;
        if (mn < M) {
#pragma unroll
            for (int j = 0; j < 4; ++j) { yn[j] = ((const GAS v2u*)(Y + (size_t)mn * D))[lane + 64 * j]; xn[j] = ((const GAS f32x4*)(xin + (size_t)mn * D))[lane + 64 * j]; } }
        const float r = 1.0f / sqrtf(wave_sum(s) * (1.0f / D) + RMS_EPS);
        f32x4 x1[4]; float s2 = 0.f;
#pragma unroll
        for (int j = 0; j < 4; ++j) { x1[j] = xi[j] + y[j] * r * gp[j]; ((GAS f32x4*)(xout + (size_t)m * D))[lane + 64 * j] = x1[j];
            s2 += (x1[j].x * x1[j].x + x1[j].y * x1[j].y) + (x1[j].z * x1[j].z + x1[j].w * x1[j].w); }
        if (HBo) {
            const float r2 = 1.0f / sqrtf(wave_sum(s2) * (1.0f / D) + RMS_EPS);
            GAS v2u* o8 = (GAS v2u*)(HBo + (size_t)m * D) + lane;
#pragma unroll
            for (int j = 0; j < 4; ++j) { v2u w; w.x = pk2(x1[j].x * r2 * gn[j].x, x1[j].y * r2 * gn[j].y); w.y = pk2(x1[j].z * r2 * gn[j].z, x1[j].w * r2 * gn[j].w); o8[64 * j] = w; }
        }
    }
}
__device__ __forceinline__ void kstat_job2(const bf16* X2, float* kbar, gu32* kmax, int job, int lane) {
    const int mixer = job >> 10, b = (job >> 9) & 1, h = (job >> 6) & 7, j = job & 63;
    const bf16* rows = X2 + (size_t)(b * SEQ + 256 * j) * 2048 + mixer * 1024 + h * 64;
    const int piece = lane & 7, rg = lane >> 3;
    float a[8]; float mx = 0.f;
#pragma unroll
    for (int i = 0; i < 8; ++i) a[i] = 0.f;
    for (int it0 = 0; it0 < 32; it0 += 8) {
        v4u w[8];
#pragma unroll
        for (int u = 0; u < 8; ++u) w[u] = *(const GAS v4u*)(rows + (size_t)((it0 + u) * 8 + rg) * 2048 + piece * 8);
#pragma unroll
        for (int u = 0; u < 8; ++u) {
            const float v0 = bflo(w[u].x), v1 = bfhi(w[u].x), v2 = bflo(w[u].y), v3 = bfhi(w[u].y), v4 = bflo(w[u].z), v5 = bfhi(w[u].z), v6 = bflo(w[u].w), v7 = bfhi(w[u].w);
            a[0] += v0; a[1] += v1; a[2] += v2; a[3] += v3; a[4] += v4; a[5] += v5; a[6] += v6; a[7] += v7;
            mx = fmaxf(mx, (v0 * v0 + v1 * v1) + (v2 * v2 + v3 * v3) + (v4 * v4 + v5 * v5) + (v6 * v6 + v7 * v7)); }
    }
#pragma unroll
    for (int i = 0; i < 8; ++i) { a[i] += __shfl_xor(a[i], 8); a[i] += __shfl_xor(a[i], 16); a[i] += __shfl_xor(a[i], 32); }
    if (mixer == 0 && lane < 8) {
        float* o = kbar + ((size_t)((b * 8 + h) * 64 + j)) * 64 + piece * 8;
#pragma unroll
        for (int i = 0; i < 8; ++i) o[i] = a[i] * (1.0f / 256.0f);
    }
    mx = fmaxf(mx, __shfl_xor(mx, 8)); mx = fmaxf(mx, __shfl_xor(mx, 16)); mx = fmaxf(mx, __shfl_xor(mx, 32));
    mx += __shfl_xor(mx, 1); mx += __shfl_xor(mx, 2); mx += __shfl_xor(mx, 4);
    if (lane == 0) __hip_atomic_fetch_max(kmax + mixer * 16 + b * 8 + h, __builtin_bit_cast(unsigned, mx), RLX_AGENT);
}
__device__ __forceinline__ void pool_rows(const bf16* UC, bf16* X1, int gw, int NGW, int lane) {
    const int c0 = lane * 8, wm1 = (2 << (lane >> 4)) - 1;
    for (int item = gw; item < M / 16; item += NGW) {
        const int r0 = item * 16, tp0 = r0 & (SEQ - 1);
        float s[8];
#pragma unroll
        for (int j = 0; j < 8; ++j) s[j] = 0.f;
        for (int k = 1; k <= 15; ++k) if (k <= wm1 && tp0 - k >= 0) {
            const v4u v = *(const GAS v4u*)(UC + (size_t)(r0 - k) * 512 + c0);
            s[0] += bflo(v.x); s[1] += bfhi(v.x); s[2] += bflo(v.y); s[3] += bfhi(v.y); s[4] += bflo(v.z); s[5] += bfhi(v.z); s[6] += bflo(v.w); s[7] += bfhi(v.w); }
#pragma unroll 4
        for (int i = 0; i < 16; ++i) {
            const int t = r0 + i, tp = tp0 + i;
            const v4u v = *(const GAS v4u*)(UC + (size_t)t * 512 + c0);
            const float f[8] = {bflo(v.x), bfhi(v.x), bflo(v.y), bfhi(v.y), bflo(v.z), bfhi(v.z), bflo(v.w), bfhi(v.w)};
#pragma unroll
            for (int j = 0; j < 8; ++j) s[j] += f[j];
            const int cnt = (tp + 1) < (wm1 + 1) ? (tp + 1) : (wm1 + 1); const float inv = 1.0f / (float)cnt;
            v4u o; o.x = pk2(s[0] * inv - f[0], s[1] * inv - f[1]); o.y = pk2(s[2] * inv - f[2], s[3] * inv - f[3]);
            o.z = pk2(s[4] * inv - f[4], s[5] * inv - f[5]); o.w = pk2(s[6] * inv - f[6], s[7] * inv - f[7]);
            *(GAS v4u*)(X1 + (size_t)t * KMRG + 1024 + c0) = o;
            if (tp - wm1 >= 0) { const v4u q = *(const GAS v4u*)(UC + (size_t)(t - wm1) * 512 + c0);
                s[0] -= bflo(q.x); s[1] -= bfhi(q.x); s[2] -= bflo(q.y); s[3] -= bfhi(q.y); s[4] -= bflo(q.z); s[5] -= bfhi(q.z); s[6] -= bflo(q.w); s[7] -= bfhi(q.w); }
        }
    }
}

__device__ __forceinline__ void nv_chunk(const float (&q)[64], const bf16* Kb, const bf16* Vb, int pos0, int pstride, bool valid, int lane, float& m_run, float& l_lane, float& acc) {
    int pos = pos0 + lane * pstride; pos = pos < 0 ? 0 : pos;
    const GAS v4u* kr = (const GAS v4u*)(Kb + (size_t)pos * 2048);
    float s = 0.f;
#pragma unroll
    for (int c = 0; c < 8; ++c) { const v4u w = kr[c];
        s += q[8 * c] * bflo(w.x) + q[8 * c + 1] * bfhi(w.x) + q[8 * c + 2] * bflo(w.y) + q[8 * c + 3] * bfhi(w.y) + q[8 * c + 4] * bflo(w.z) + q[8 * c + 5] * bfhi(w.z) + q[8 * c + 6] * bflo(w.w) + q[8 * c + 7] * bfhi(w.w); }
    s = valid ? s : -1e30f;
    const float cm = wave_max(s), mn = fmaxf(m_run, cm), alpha = __builtin_amdgcn_exp2f(m_run - mn);
    const float p = valid ? __builtin_amdgcn_exp2f(s - mn) : 0.f;
    l_lane = l_lane * alpha + p;
    float a = 0.f;
#pragma unroll 16
    for (int kk = 0; kk < 64; ++kk) {
        const float pk = __builtin_bit_cast(float, __builtin_amdgcn_readlane(__builtin_bit_cast(int, p), kk));
        int pp = pos0 + kk * pstride; pp = pp < 0 ? 0 : pp;
        a += pk * bf1(Vb[(size_t)pp * 2048 + lane]);
    }
    acc = acc * alpha + a; m_run = mn;
}
__device__ __forceinline__ void nv_load_q(float (&q)[64], const bf16* qrow) {
#pragma unroll
    for (int c = 0; c < 8; ++c) { const v4u w = ((const GAS v4u*)qrow)[c];
        q[8 * c] = bflo(w.x); q[8 * c + 1] = bfhi(w.x); q[8 * c + 2] = bflo(w.y); q[8 * c + 3] = bfhi(w.y); q[8 * c + 4] = bflo(w.z); q[8 * c + 5] = bfhi(w.z); q[8 * c + 6] = bflo(w.w); q[8 * c + 7] = bfhi(w.w); }
}
__device__ __forceinline__ void nv_moba(bf16* X1, const bf16* X2, const float* kbar, int b, int t, int h, int lane) {
    bf16* qrow = X1 + (size_t)(b * SEQ + t) * KMRG + h * 64;
    float q[64]; nv_load_q(q, qrow);
    const bf16* Kb = X2 + (size_t)b * SEQ * 2048 + h * 64; const bf16* Vb = Kb + 512;
    const int n = t >> 8;
    float sc = -INFINITY;
    if (lane < n) { const GAS f32x4* kb = (const GAS f32x4*)(kbar + ((size_t)((b * 8 + h) * 64 + lane)) * 64); float s = 0.f;
#pragma unroll
        for (int c = 0; c < 16; ++c) { const f32x4 w = kb[c]; s += q[4 * c] * w.x + q[4 * c + 1] * w.y + q[4 * c + 2] * w.z + q[4 * c + 3] * w.w; }
        sc = s; }
    float m_run = -1e30f, l_lane = 0.f, acc = 0.f;
    for (int r = 0; r < 3; ++r) {
        float bv = sc; int bi = lane;
#pragma unroll
        for (int o = 1; o < 64; o <<= 1) { const float ov = __shfl_xor(bv, o); const int oi = __shfl_xor(bi, o); if (ov > bv || (ov == bv && oi < bi)) { bv = ov; bi = oi; } }
        if (!(bv > -INFINITY)) break;
        bi = __builtin_amdgcn_readfirstlane(bi);
        if (lane == bi) sc = -INFINITY;
        for (int c = 0; c < 4; ++c) nv_chunk(q, Kb, Vb, bi * 256 + 64 * c, 1, true, lane, m_run, l_lane, acc);
    }
    const int nc = ((t & 255) >> 6) + 1;
    for (int c = 0; c < nc; ++c) { const int pos0 = n * 256 + 64 * c; nv_chunk(q, Kb, Vb, pos0, 1, (pos0 + lane) <= t, lane, m_run, l_lane, acc); }
    const float o = acc / wave_sum(l_lane);
    qrow[lane] = (bf16)f2bf(o);
}
__device__ __forceinline__ void nv_dil(bf16* X1, const bf16* X2, int b, int t, int h, int lane) {
    bf16* qrow = X1 + (size_t)(b * SEQ + t) * KMRG + 512 + h * 64;
    float q[64]; nv_load_q(q, qrow);
    const bf16* Kb = X2 + (size_t)b * SEQ * 2048 + 1024 + h * 64; const bf16* Vb = Kb + 512;
    float m_run = -1e30f, l_lane = 0.f, acc = 0.f;
#pragma unroll
    for (int p = 0; p < 3; ++p) { const int d = p == 0 ? 1 : (p == 1 ? 4 : 16);
        for (int c = 0; c < 3; ++c) { const int mm = 64 * c + lane; nv_chunk(q, Kb, Vb, t - 64 * c * d, -d, (mm <= 128) && (t - mm * d >= 0), lane, m_run, l_lane, acc); } }
    const float o = acc / wave_sum(l_lane);
    qrow[lane] = (bf16)f2bf(o);
}

typedef short bf16x8 __attribute__((ext_vector_type(8)));
typedef short s16x4 __attribute__((ext_vector_type(4)));
typedef float f32x16 __attribute__((ext_vector_type(16)));
typedef float f32x2_t __attribute__((ext_vector_type(2)));
typedef __bf16 bf16x2_t __attribute__((ext_vector_type(2)));
#define MFMA32(a, b, c) __builtin_amdgcn_mfma_f32_32x32x16_bf16((a), (b), (c), 0, 0, 0)
constexpr int VT_PITCH = 144, VT_BYTES = 32 * VT_PITCH;
constexpr int LIST_PER_BH = 256 * 2016;
__device__ __forceinline__ int list_off(int j) { return 256 * (63 * j - (j * (j - 1)) / 2); }
__device__ __forceinline__ unsigned cvtpk(float lo, float hi) { f32x2_t v = {lo, hi}; bf16x2_t b = __builtin_convertvector(v, bf16x2_t); return __builtin_bit_cast(unsigned, b); }
__device__ __forceinline__ s16x4 vtr(LAS const char* p) { return __builtin_bit_cast(s16x4, __builtin_amdgcn_ds_read_tr16_b64_v4i16((LAS s16x4*)p)); }

__device__ __forceinline__ void at_load(const bf16* Kb, const bf16* Vb, int p0, int ps, int r32, int hi, int lane, bf16x8 (&kf)[4], v4u (&vr)[4]) {
    int pk = p0 + r32 * ps; pk = pk < 0 ? 0 : pk;
    const bf16* kr = Kb + (size_t)pk * 2048 + 8 * hi;
#pragma unroll
    for (int s = 0; s < 4; ++s) kf[s] = *(const GAS bf16x8*)(kr + 16 * s);
#pragma unroll
    for (int it = 0; it < 4; ++it) { const int c = it * 64 + lane, key = c >> 3, piece = c & 7; int pv = p0 + key * ps; pv = pv < 0 ? 0 : pv;
        vr[it] = *(const GAS v4u*)(Vb + (size_t)pv * 2048 + piece * 8); }
}
__device__ __forceinline__ void at_stage_v(LAS char* vl, const v4u (&vr)[4], int lane) {
#pragma unroll
    for (int it = 0; it < 4; ++it) { const int c = it * 64 + lane, key = c >> 3, piece = c & 7; *(LAS v4u*)(vl + key * VT_PITCH + piece * 16) = vr[it]; }
}
template <bool MASK>
__device__ __forceinline__ void at_compute(const bf16x8 (&qf)[4], const bf16x8 (&kf)[4], LAS const char* vl, float shift, int kbase, int klo, int khi, int hi, int lane, f32x16& o0, f32x16& o1, float& l) {
    f32x16 s;
#pragma unroll
    for (int i = 0; i < 16; ++i) s[i] = 0.f;
#pragma unroll
    for (int k = 0; k < 4; ++k) s = MFMA32(kf[k], qf[k], s);
    float p[16];
#pragma unroll
    for (int i = 0; i < 16; ++i) { float pe = __builtin_amdgcn_exp2f(s[i] - shift);
        if (MASK) { const int kidx = kbase + (i & 3) + 8 * (i >> 2) + 4 * hi; pe = (kidx >= klo && kidx <= khi) ? pe : 0.f; }
        p[i] = pe; l += pe; }
    bf16x8 pf[2];
#pragma unroll
    for (int sp = 0; sp < 2; ++sp) { v4u w; w.x = cvtpk(p[8 * sp], p[8 * sp + 1]); w.y = cvtpk(p[8 * sp + 2], p[8 * sp + 3]); w.z = cvtpk(p[8 * sp + 4], p[8 * sp + 5]); w.w = cvtpk(p[8 * sp + 6], p[8 * sp + 7]); pf[sp] = __builtin_bit_cast(bf16x8, w); }
    const int q4 = (lane & 15) >> 2, p4 = lane & 3, blk = (lane >> 4) & 1;
    LAS const char* vb = vl + (4 * hi + q4) * VT_PITCH + (16 * blk + 4 * p4) * 2;
#pragma unroll
    for (int sp = 0; sp < 2; ++sp) {
        const s16x4 a0 = vtr(vb + (16 * sp) * VT_PITCH), a1 = vtr(vb + (16 * sp + 8) * VT_PITCH);
        const s16x4 b0 = vtr(vb + (16 * sp) * VT_PITCH + 64), b1 = vtr(vb + (16 * sp + 8) * VT_PITCH + 64);
        const bf16x8 v0 = __builtin_shufflevector(a0, a1, 0, 1, 2, 3, 4, 5, 6, 7), v1 = __builtin_shufflevector(b0, b1, 0, 1, 2, 3, 4, 5, 6, 7);
        o0 = MFMA32(v0, pf[sp], o0); o1 = MFMA32(v1, pf[sp], o1);
    }
}
template <int MASKMODE>
__device__ __forceinline__ void at_run(const bf16x8 (&qf)[4], float shift, const bf16* Kb, const bf16* Vb, int p0, int ps, int kt_lo, int kt_hi, int klo, int khi, LAS char* vl, int lane, f32x16& o0, f32x16& o1, float& l) {
    const int r32 = lane & 31, hi = lane >> 5;
    if (kt_lo >= kt_hi) return;
    bf16x8 kf[4], kn[4]; v4u vr[4], vn[4];
    at_load(Kb, Vb, p0 + 32 * kt_lo * ps, ps, r32, hi, lane, kf, vr);
    for (int kt = kt_lo; kt < kt_hi; ++kt) {
        at_stage_v(vl, vr, lane);
        const bool more = kt + 1 < kt_hi;
        if (more) at_load(Kb, Vb, p0 + 32 * (kt + 1) * ps, ps, r32, hi, lane, kn, vn);
        if (MASKMODE == 1 || (MASKMODE == 2 && !more)) at_compute<true>(qf, kf, vl, shift, 32 * kt, klo, khi, hi, lane, o0, o1, l);
        else at_compute<false>(qf, kf, vl, shift, 32 * kt, klo, khi, hi, lane, o0, o1, l);
        if (more) {
#pragma unroll
            for (int k = 0; k < 4; ++k) { kf[k] = kn[k]; vr[k] = vn[k]; } }
    }
}
__device__ __forceinline__ float at_load_q(const bf16* qrow, int hi, float kmax2, bf16x8 (&qf)[4]) {
    float ss = 0.f;
#pragma unroll
    for (int s = 0; s < 4; ++s) { qf[s] = *(const GAS bf16x8*)(qrow + 16 * s + 8 * hi);
#pragma unroll
        for (int j = 0; j < 8; ++j) { const float f = bf1((bf16)qf[s][j]); ss += f * f; } }
    ss += __shfl_xor(ss, 32);
    return sqrtf(ss * kmax2) * 1.0002f + 1e-6f;
}
#define AT_ZERO(o0, o1, l) do { _Pragma("unroll") for (int _i = 0; _i < 16; ++_i) { o0[_i] = 0.f; o1[_i] = 0.f; } l = 0.f; } while (0)
__device__ __forceinline__ void at_store_bf16(bf16* row, int hi, const f32x16& o0, const f32x16& o1, float sc) {
#pragma unroll
    for (int g = 0; g < 4; ++g) { v2u w; w.x = cvtpk(o0[4 * g] * sc, o0[4 * g + 1] * sc); w.y = cvtpk(o0[4 * g + 2] * sc, o0[4 * g + 3] * sc); *(GAS v2u*)(row + 8 * g + 4 * hi) = w;
        v2u x; x.x = cvtpk(o1[4 * g] * sc, o1[4 * g + 1] * sc); x.y = cvtpk(o1[4 * g + 2] * sc, o1[4 * g + 3] * sc); *(GAS v2u*)(row + 32 + 8 * g + 4 * hi) = x; }
}
template <bool SC1>
__device__ __forceinline__ void at_add_bf16(const bf16* row, int hi, f32x16& o0, f32x16& o1) {
#pragma unroll
    for (int g = 0; g < 4; ++g) {
        unsigned long long a, b;
        if (SC1) { a = __hip_atomic_load((const GAS unsigned long long*)(row + 8 * g + 4 * hi), RLX_AGENT); b = __hip_atomic_load((const GAS unsigned long long*)(row + 32 + 8 * g + 4 * hi), RLX_AGENT); }
        else { a = *(const GAS unsigned long long*)(row + 8 * g + 4 * hi); b = *(const GAS unsigned long long*)(row + 32 + 8 * g + 4 * hi); }
        const unsigned a0 = (unsigned)a, a1 = (unsigned)(a >> 32), b0 = (unsigned)b, b1 = (unsigned)(b >> 32);
        o0[4 * g] += bflo(a0); o0[4 * g + 1] += bfhi(a0); o0[4 * g + 2] += bflo(a1); o0[4 * g + 3] += bfhi(a1);
        o1[4 * g] += bflo(b0); o1[4 * g + 1] += bfhi(b0); o1[4 * g + 2] += bflo(b1); o1[4 * g + 3] += bfhi(b1); }
}

__device__ __forceinline__ void moba_gate_job(const bf16* X1, const float* kbar, gu32* gcnt, bf16* LIST, int job, LAS unsigned char* lds, int tid) {
    const int bh = job >> 5, c = job & 31, b = bh >> 3, h = bh & 7, t = 512 * c + tid, n = t >> 8, nbmax = 2 * c + 1;
    LAS float* kb = (LAS float*)lds;
    LAS unsigned* hist = (LAS unsigned*)(lds + 16384); LAS unsigned* base = hist + 64; LAS unsigned* cur = hist + 128;
    __syncthreads();
    for (int i = tid; i < nbmax * 16; i += NWAVES * 64) ((LAS f32x4*)kb)[i] = ((const GAS f32x4*)(kbar + (size_t)bh * 4096))[i];
    if (tid < 64) { hist[tid] = 0u; cur[tid] = 0u; }
    __syncthreads();
    float q[64]; nv_load_q(q, X1 + (size_t)(b * SEQ + t) * KMRG + h * 64);
    float v0 = -INFINITY, v1 = -INFINITY, v2 = -INFINITY; int i0 = 0, i1 = 0, i2 = 0;
    for (int j = 0; j < n; ++j) {
        const LAS f32x4* kr = (const LAS f32x4*)(kb + j * 64); float s = 0.f;
#pragma unroll
        for (int cc = 0; cc < 16; ++cc) { const f32x4 w = kr[cc]; s += q[4 * cc] * w.x + q[4 * cc + 1] * w.y + q[4 * cc + 2] * w.z + q[4 * cc + 3] * w.w; }
        if (s > v2) { if (s > v1) { v2 = v1; i2 = i1; if (s > v0) { v1 = v0; i1 = i0; v0 = s; i0 = j; } else { v1 = s; i1 = j; } } else { v2 = s; i2 = j; } }
    }
    const int nv = n < 3 ? n : 3;
    if (nv > 0) __hip_atomic_fetch_add(hist + i0, 1u, __ATOMIC_RELAXED, __HIP_MEMORY_SCOPE_WORKGROUP);
    if (nv > 1) __hip_atomic_fetch_add(hist + i1, 1u, __ATOMIC_RELAXED, __HIP_MEMORY_SCOPE_WORKGROUP);
    if (nv > 2) __hip_atomic_fetch_add(hist + i2, 1u, __ATOMIC_RELAXED, __HIP_MEMORY_SCOPE_WORKGROUP);
    __syncthreads();
    if (tid < 64) { const unsigned hcount = hist[tid]; base[tid] = hcount ? __hip_atomic_fetch_add(gcnt + bh * 64 + tid, hcount, RLX_AGENT) : 0u; }
    __syncthreads();
    bf16* Lb = LIST + (size_t)bh * LIST_PER_BH;
    if (nv > 0) { const unsigned pos = base[i0] + __hip_atomic_fetch_add(cur + i0, 1u, __ATOMIC_RELAXED, __HIP_MEMORY_SCOPE_WORKGROUP); Lb[list_off(i0) + pos] = (bf16)(t | (0 << 14)); }
    if (nv > 1) { const unsigned pos = base[i1] + __hip_atomic_fetch_add(cur + i1, 1u, __ATOMIC_RELAXED, __HIP_MEMORY_SCOPE_WORKGROUP); Lb[list_off(i1) + pos] = (bf16)(t | (1 << 14)); }
    if (nv > 2) { const unsigned pos = base[i2] + __hip_atomic_fetch_add(cur + i2, 1u, __ATOMIC_RELAXED, __HIP_MEMORY_SCOPE_WORKGROUP); Lb[list_off(i2) + pos] = (bf16)(t | (2 << 14)); }
}
__device__ __forceinline__ void moba_sel_job(const bf16* X1, const bf16* X2, const bf16* LIST, bf16* PO, float* PL, int bh, int j, int chunk, int cnt, float kmax2, LAS char* vl, int lane) {
    const int b = bh >> 3, h = bh & 7, r32 = lane & 31, hi = lane >> 5;
    const int ei = 32 * chunk + r32; const bool vq = ei < cnt;
    const unsigned e = LIST[(size_t)bh * LIST_PER_BH + list_off(j) + (vq ? ei : 32 * chunk)];
    const int t = e & 0x3fff, slot = e >> 14;
    const size_t row = (size_t)(b * SEQ + t);
    bf16x8 qf[4]; const float shift = at_load_q(X1 + row * KMRG + h * 64, hi, kmax2, qf);
    f32x16 o0, o1; float l; AT_ZERO(o0, o1, l);
    const bf16* Kb = X2 + (size_t)b * SEQ * 2048 + h * 64;
    at_run<0>(qf, shift, Kb, Kb + 512, 256 * j, 1, 0, 8, 0, 0, vl, lane, o0, o1, l);
    l += __shfl_xor(l, 32);
    if (vq) { at_store_bf16(PO + ((row * 8 + h) * 3 + slot) * 64, hi, o0, o1, 1.0f); if (hi == 0) PL[(row * 8 + h) * 3 + slot] = l; }
}
__device__ __forceinline__ void moba_own_job(bf16* X1, const bf16* X2, const bf16* PO, const float* PL, int job, float kmax2, LAS char* vl, int lane) {
    const int bh = job >> 9, n = (job >> 3) & 63, i = job & 7, b = bh >> 3, h = bh & 7, r32 = lane & 31, hi = lane >> 5;
    const int t = 256 * n + 32 * i + r32; const size_t row = (size_t)(b * SEQ + t);
    bf16* qrow = X1 + row * KMRG + h * 64;
    bf16x8 qf[4]; const float shift = at_load_q(qrow, hi, kmax2, qf);
    f32x16 o0, o1; float l; AT_ZERO(o0, o1, l);
    const bf16* Kb = X2 + (size_t)b * SEQ * 2048 + h * 64;
    at_run<2>(qf, shift, Kb, Kb + 512, 256 * n, 1, 0, i + 1, 0, 32 * i + r32, vl, lane, o0, o1, l);
    l += __shfl_xor(l, 32);
    const int nv = n < 3 ? n : 3;
    for (int s = 0; s < nv; ++s) { at_add_bf16<false>(PO + ((row * 8 + h) * 3 + s) * 64, hi, o0, o1); l += PL[(row * 8 + h) * 3 + s]; }
    at_store_bf16(qrow, hi, o0, o1, 1.0f / l);
}
__device__ __forceinline__ void dil_x_job(const bf16* X1, const bf16* X2, bf16* DO, float* DL, int unit, float kmax2, LAS char* vl, int lane) {
    const int bh = unit >> 7, P0 = (unit & 127) * 128, b = bh >> 3, h = bh & 7, r32 = lane & 31, hi = lane >> 5;
    const bf16* Kb = X2 + (size_t)b * SEQ * 2048 + 1024 + h * 64;
    for (int qt = 0; qt < 4; ++qt) {
        const int L0 = P0 + 32 * qt; const size_t row = (size_t)(b * SEQ + L0 + r32);
        bf16x8 qf[4]; const float shift = at_load_q(X1 + row * KMRG + 512 + h * 64, hi, kmax2, qf);
        f32x16 o0, o1; float l; AT_ZERO(o0, o1, l);
        const int klo = r32 > 128 - L0 ? r32 : 128 - L0, ktlo = L0 >= 128 ? 0 : (128 - L0) >> 5;
        at_run<1>(qf, shift, Kb, Kb + 512, L0 - 128, 1, ktlo, 5, klo, 128 + r32, vl, lane, o0, o1, l);
        l += __shfl_xor(l, 32);
        at_store_bf16(DO + row * 512 + h * 64, hi, o0, o1, 1.0f); if (hi == 0) DL[row * 8 + h] = l;
    }
    asm volatile("s_waitcnt vmcnt(0)" ::: "memory");
    for (int rr = 0; rr < 4; ++rr) {
        const int L0 = P0 >> 2; const size_t row = (size_t)(b * SEQ + P0 + rr + 4 * r32);
        bf16x8 qf[4]; const float shift = at_load_q(X1 + row * KMRG + 512 + h * 64, hi, kmax2, qf);
        f32x16 o0, o1; float l; AT_ZERO(o0, o1, l);
        const int klo = r32 > 128 - L0 ? r32 : 128 - L0, ktlo = L0 >= 128 ? 0 : (128 - L0) >> 5;
        at_run<1>(qf, shift, Kb, Kb + 512, rr + 4 * (L0 - 128), 4, ktlo, 5, klo, 128 + r32, vl, lane, o0, o1, l);
        l += __shfl_xor(l, 32);
        at_add_bf16<true>(DO + row * 512 + h * 64, hi, o0, o1);
        at_store_bf16(DO + row * 512 + h * 64, hi, o0, o1, 1.0f);
        if (hi == 0) DL[row * 8 + h] = l + __hip_atomic_load((const GAS float*)(DL + row * 8 + h), RLX_AGENT);
    }
}
__device__ __forceinline__ void dil_y_job(bf16* X1, const bf16* X2, const bf16* DO, const float* DL, int job, float kmax2, LAS char* vl, int lane) {
    const int bh = job >> 9, P0 = ((job >> 4) & 31) * 512, rr = job & 15, b = bh >> 3, h = bh & 7, r32 = lane & 31, hi = lane >> 5;
    const bf16* Kb = X2 + (size_t)b * SEQ * 2048 + 1024 + h * 64;
    const int L0 = P0 >> 4; const size_t row = (size_t)(b * SEQ + P0 + rr + 16 * r32);
    bf16* qrow = X1 + row * KMRG + 512 + h * 64;
    bf16x8 qf[4]; const float shift = at_load_q(qrow, hi, kmax2, qf);
    f32x16 o0, o1; float l; AT_ZERO(o0, o1, l);
    const int klo = r32 > 128 - L0 ? r32 : 128 - L0, ktlo = L0 >= 128 ? 0 : (128 - L0) >> 5;
    at_run<1>(qf, shift, Kb, Kb + 512, rr + 16 * (L0 - 128), 16, ktlo, 5, klo, 128 + r32, vl, lane, o0, o1, l);
    l += __shfl_xor(l, 32);
    at_add_bf16<false>(DO + row * 512 + h * 64, hi, o0, o1); l += DL[row * 8 + h];
    at_store_bf16(qrow, hi, o0, o1, 1.0f / l);
}


#if ATTN_CHECK
__device__ __forceinline__ int chk_pos(int i) { return i < 64 ? i : i < 96 ? 2032 + (i - 64) : i < 128 ? 496 + (i - 96) : i < 160 ? 16383 - (i - 128) : (int)(((unsigned)i * 2654435761u >> 18) & 16383u); }
__device__ __forceinline__ void chk_ref_job(const bf16* X1, const bf16* X2, const float* kbar, float* CHK, int job, int lane) {
    const int mixer = job >> 12, b = (job >> 11) & 1, i = (job >> 3) & 255, h = job & 7, t = chk_pos(i);
    const bf16* qrow = X1 + (size_t)(b * SEQ + t) * KMRG + mixer * 512 + h * 64;
    float q[64]; nv_load_q(q, qrow);
    float m_run = -1e30f, l_lane = 0.f, acc = 0.f;
    if (mixer == 0) {
        const bf16* Kb = X2 + (size_t)b * SEQ * 2048 + h * 64; const bf16* Vb = Kb + 512;
        const int n = t >> 8; float sc = -INFINITY;
        if (lane < n) { const GAS f32x4* kb = (const GAS f32x4*)(kbar + ((size_t)((b * 8 + h) * 64 + lane)) * 64); float s = 0.f;
#pragma unroll
            for (int c = 0; c < 16; ++c) { const f32x4 w = kb[c]; s += q[4 * c] * w.x + q[4 * c + 1] * w.y + q[4 * c + 2] * w.z + q[4 * c + 3] * w.w; }
            sc = s; }
        for (int r = 0; r < 3; ++r) {
            float bv = sc; int bi = lane;
#pragma unroll
            for (int o = 1; o < 64; o <<= 1) { const float ov = __shfl_xor(bv, o); const int oi = __shfl_xor(bi, o); if (ov > bv || (ov == bv && oi < bi)) { bv = ov; bi = oi; } }
            if (!(bv > -INFINITY)) break;
            bi = __builtin_amdgcn_readfirstlane(bi);
            if (lane == bi) sc = -INFINITY;
            for (int c = 0; c < 4; ++c) nv_chunk(q, Kb, Vb, bi * 256 + 64 * c, 1, true, lane, m_run, l_lane, acc);
        }
        const int nc = ((t & 255) >> 6) + 1;
        for (int c = 0; c < nc; ++c) { const int pos0 = n * 256 + 64 * c; nv_chunk(q, Kb, Vb, pos0, 1, (pos0 + lane) <= t, lane, m_run, l_lane, acc); }
    } else {
        const bf16* Kb = X2 + (size_t)b * SEQ * 2048 + 1024 + h * 64; const bf16* Vb = Kb + 512;
#pragma unroll
        for (int p = 0; p < 3; ++p) { const int d = p == 0 ? 1 : (p == 1 ? 4 : 16);
            for (int c = 0; c < 3; ++c) { const int mm = 64 * c + lane; nv_chunk(q, Kb, Vb, t - 64 * c * d, -d, (mm <= 128) && (t - mm * d >= 0), lane, m_run, l_lane, acc); } }
    }
    CHK[(size_t)job * 64 + lane] = acc / wave_sum(l_lane);
}
__device__ __forceinline__ void chk_cmp_job(const bf16* X1, const float* CHK, float* sums, int job, int lane) {
    const int mixer = job >> 12, b = (job >> 11) & 1, i = (job >> 3) & 255, h = job & 7, t = chk_pos(i);
    const float ref = CHK[(size_t)job * 64 + lane], fast = bf1(X1[(size_t)(b * SEQ + t) * KMRG + mixer * 512 + h * 64 + lane]);
    const float d2 = wave_sum((fast - ref) * (fast - ref)), r2 = wave_sum(ref * ref);
    if (lane == 0) { atomicAdd(sums + mixer * 2, d2); atomicAdd(sums + mixer * 2 + 1, r2); }
}
#endif
constexpr int IMG_PITCH = 144, VIMG_OFF = 384 * IMG_PITCH, IMG_BYTES = 2 * VIMG_OFF;
constexpr int KML_OFF = 121088;
constexpr int PREF2_OFF = 112640;
template <int NPC>
__device__ __forceinline__ void img_load(const bf16* Kb, int p0, int ps, int tid, v4u (&r)[NPC]) {
#pragma unroll
    for (int it = 0; it < NPC; ++it) { const bool isv = it >= NPC / 2; const int cc = (isv ? it - NPC / 2 : it) * 512 + tid, key = cc >> 3, piece = cc & 7; int pos = p0 + key * ps; pos = pos < 0 ? 0 : pos;
        r[it] = *(const GAS v4u*)(Kb + (size_t)pos * 2048 + (isv ? 512 : 0) + piece * 8); }
}
template <int NPC>
__device__ __forceinline__ void img_store(LAS char* img, int tid, const v4u (&r)[NPC]) {
#pragma unroll
    for (int it = 0; it < NPC; ++it) { const bool isv = it >= NPC / 2; const int cc = (isv ? it - NPC / 2 : it) * 512 + tid, key = cc >> 3, piece = cc & 7;
        *(LAS v4u*)(img + (isv ? VIMG_OFF : 0) + key * IMG_PITCH + piece * 16) = r[it]; }
}
__device__ __forceinline__ void load_qf(const bf16* qrow, int hi, bf16x8 (&qf)[4]) {
#pragma unroll
    for (int s = 0; s < 4; ++s) qf[s] = *(const GAS bf16x8*)(qrow + 16 * s + 8 * hi);
}
__device__ __forceinline__ float q_shift(const bf16x8 (&qf)[4], float kmax2) {
    float ss = 0.f;
#pragma unroll
    for (int s = 0; s < 4; ++s)
#pragma unroll
        for (int j = 0; j < 8; ++j) { const float f = bf1((bf16)qf[s][j]); ss += f * f; }
    ss += __shfl_xor(ss, 32);
    return sqrtf(ss * kmax2) * 1.0002f + 1e-6f;
}
template <bool MASK>
__device__ __forceinline__ void at2_tile(const bf16x8 (&qf)[4], const f32x16& negm, LAS const char* img, int kt, int klo, int khi, int hi, int lane, f32x16& o0, f32x16& o1, float& l) {
    LAS const char* kp = img + (32 * kt + (lane & 31)) * IMG_PITCH + 16 * hi;
    bf16x8 kf[4];
#pragma unroll
    for (int k = 0; k < 4; ++k) kf[k] = *(LAS const bf16x8*)(kp + 32 * k);
    f32x16 s = MFMA32(kf[0], qf[0], negm);
#pragma unroll
    for (int k = 1; k < 4; ++k) s = MFMA32(kf[k], qf[k], s);
    float p[16];
#pragma unroll
    for (int i = 0; i < 16; ++i) { float pe = __builtin_amdgcn_exp2f(s[i]);
        if (MASK) { const int kidx = 32 * kt + (i & 3) + 8 * (i >> 2) + 4 * hi; pe = (kidx >= klo && kidx <= khi) ? pe : 0.f; }
        p[i] = pe; l += pe; }
    bf16x8 pf[2];
#pragma unroll
    for (int sp = 0; sp < 2; ++sp) { v4u w; w.x = cvtpk(p[8 * sp], p[8 * sp + 1]); w.y = cvtpk(p[8 * sp + 2], p[8 * sp + 3]); w.z = cvtpk(p[8 * sp + 4], p[8 * sp + 5]); w.w = cvtpk(p[8 * sp + 6], p[8 * sp + 7]); pf[sp] = __builtin_bit_cast(bf16x8, w); }
    const int q4 = (lane & 15) >> 2, p4 = lane & 3, blk = (lane >> 4) & 1;
    LAS const char* vb = img + VIMG_OFF + (32 * kt + 4 * hi + q4) * IMG_PITCH + (16 * blk + 4 * p4) * 2;
#pragma unroll
    for (int sp = 0; sp < 2; ++sp) {
        const s16x4 a0 = vtr(vb + (16 * sp) * IMG_PITCH), a1 = vtr(vb + (16 * sp + 8) * IMG_PITCH);
        const s16x4 b0 = vtr(vb + (16 * sp) * IMG_PITCH + 64), b1 = vtr(vb + (16 * sp + 8) * IMG_PITCH + 64);
        const bf16x8 v0 = __builtin_shufflevector(a0, a1, 0, 1, 2, 3, 4, 5, 6, 7), v1 = __builtin_shufflevector(b0, b1, 0, 1, 2, 3, 4, 5, 6, 7);
        o0 = MFMA32(v0, pf[sp], o0); o1 = MFMA32(v1, pf[sp], o1);
    }
}
__device__ __forceinline__ void at2_run(const bf16x8 (&qf)[4], float shift, LAS const char* img, int kt_lo, int kt_hi, int km0, int km1, bool mall, int klo, int khi, int hi, int lane, f32x16& o0, f32x16& o1, float& l) {
    f32x16 negm;
#pragma unroll
    for (int i = 0; i < 16; ++i) negm[i] = -shift;
    for (int kt = kt_lo; kt < kt_hi; ++kt) {
        if (mall || kt == km0 || kt == km1) at2_tile<true>(qf, negm, img, kt, klo, khi, hi, lane, o0, o1, l);
        else at2_tile<false>(qf, negm, img, kt, klo, khi, hi, lane, o0, o1, l);
    }
}
#define QCOPY(dst, src) do { _Pragma("unroll") for (int _k = 0; _k < 4; ++_k) dst[_k] = src[_k]; } while (0)

__device__ __forceinline__ void dil_x_unit(const bf16* X1, const bf16* X2, bf16* DO, float* DL, int u, LAS char* img, int tid) {
    const int lane = tid & 63, w = __builtin_amdgcn_readfirstlane(tid >> 6), r32 = lane & 31, hi = lane >> 5;
    const int bh = u >> 4, S0 = (u & 15) * 1024, b = bh >> 3, h = bh & 7; const float kmax2 = ((LAS const float*)(img + KML_OFF))[16 + bh];
    const bf16* Kb = X2 + (size_t)b * SEQ * 2048 + 1024 + h * 64;
    const bf16* Qb = X1 + (size_t)b * SEQ * KMRG + 512 + h * 64;
    v4u ir[12]; bf16x8 qn[4], qf[4];
    img_load<12>(Kb, S0 - 128, 1, tid, ir);
    load_qf(Qb + (size_t)(S0 + 32 * w + r32) * KMRG, hi, qn);
    for (int i = 0; i < 8; ++i) {
        if (i == 4) asm volatile("s_waitcnt vmcnt(0)" ::: "memory");
        __syncthreads(); img_store<12>(img, tid, ir); __syncthreads();
        QCOPY(qf, qn);
        const int qpos = i < 4 ? S0 + 256 * i + 32 * w + r32 : S0 + (i - 4) + 4 * (32 * w + r32);
        if (i < 7) { const int j = i + 1;
            if (j < 4) { img_load<12>(Kb, S0 + 256 * j - 128, 1, tid, ir); load_qf(Qb + (size_t)(S0 + 256 * j + 32 * w + r32) * KMRG, hi, qn); }
            else { img_load<12>(Kb, (j - 4) + S0 - 512, 4, tid, ir); load_qf(Qb + (size_t)(S0 + (j - 4) + 4 * (32 * w + r32)) * KMRG, hi, qn); } }
        const int Lb = i < 4 ? S0 + 256 * i : S0 >> 2;
        const float shift = q_shift(qf, kmax2);
        f32x16 o0, o1; float l; AT_ZERO(o0, o1, l);
        const int own = 32 * w + r32, klo = Lb == 0 ? (own > 128 ? own : 128) : own;
        at2_run(qf, shift, img, (Lb == 0 && w < 4) ? 4 : w, w + 5, w, w + 4, Lb == 0, klo, own + 128, hi, lane, o0, o1, l);
        l += __shfl_xor(l, 32);
        const size_t row = (size_t)(b * SEQ + qpos);
        if (i >= 4) { at_add_bf16<true>(DO + row * 512 + h * 64, hi, o0, o1); l += __hip_atomic_load((const GAS float*)(DL + row * 8 + h), RLX_AGENT); }
        at_store_bf16(DO + row * 512 + h * 64, hi, o0, o1, 1.0f); if (hi == 0) DL[row * 8 + h] = l;
    }
}
__device__ __forceinline__ void moba_sel_items(const bf16* X1, const bf16* X2, const bf16* LIST, bf16* PO, float* PL, gu32* gcnt, LAS unsigned char* lds, int tid, int G) {
    const int lane = tid & 63, w = __builtin_amdgcn_readfirstlane(tid >> 6), r32 = lane & 31, hi = lane >> 5;
    LAS unsigned* pref = (LAS unsigned*)(lds + PREF2_OFF); LAS unsigned* wtot = pref + 1032; LAS unsigned* cnts = pref + 1040; LAS const float* kml = (LAS const float*)(lds + KML_OFF); LAS char* img = (LAS char*)lds;
    { const unsigned c0 = __hip_atomic_load(gcnt + 2 * tid, RLX_AGENT), c1 = __hip_atomic_load(gcnt + 2 * tid + 1, RLX_AGENT);
      const unsigned a = (c0 + 255u) >> 8, b2 = (c1 + 255u) >> 8; unsigned sc = a + b2;
#pragma unroll
      for (int o = 1; o < 64; o <<= 1) { const unsigned v = __shfl_up(sc, o); if (lane >= o) sc += v; }
      if (lane == 63) wtot[w] = sc;
      cnts[2 * tid] = c0; cnts[2 * tid + 1] = c1;
      __syncthreads();
      unsigned woff = 0; for (int x = 0; x < w; ++x) woff += wtot[x];
      const unsigned ex = woff + sc - (a + b2);
      pref[2 * tid] = ex; pref[2 * tid + 1] = ex + a; if (tid == NWAVES * 64 - 1) pref[1024] = ex + a + b2;
      __syncthreads(); }
    const int T = (int)pref[1024];
    v4u ir[8]; bf16x8 qn[4], qf[4];
    int lo1 = 0, g1 = 0, lo2 = 0, g2 = 0; unsigned e1 = 0, e2 = 0;
#define SEL_DECODE(it, LO, GG) do { int lo_ = 0, hi_ = 1024; while (hi_ - lo_ > 1) { const int mid = (lo_ + hi_) >> 1; if ((int)pref[mid] <= (it)) lo_ = mid; else hi_ = mid; } LO = lo_; GG = (it) - (int)pref[lo_]; } while (0)
#define SEL_ENTRY(LO, GG, E) do { const int ei_ = 256 * (GG) + 32 * w + r32; const bool vq_ = ei_ < (int)cnts[LO]; \
        E = (unsigned)LIST[(size_t)((LO) >> 6) * LIST_PER_BH + list_off((LO) & 63) + (vq_ ? ei_ : 256 * (GG))] | (vq_ ? 0x10000u : 0u); } while (0)
#define SEL_STAGE(LO, E) do { const int b_ = (LO) >> 9, h_ = ((LO) >> 6) & 7; img_load<8>(X2 + (size_t)b_ * SEQ * 2048 + h_ * 64, 256 * ((LO) & 63), 1, tid, ir); \
        load_qf(X1 + (size_t)(b_ * SEQ + (int)((E) & 0x3fffu)) * KMRG + h_ * 64, hi, qn); } while (0)
    int item = blockIdx.x;
    if (item < T) { SEL_DECODE(item, lo1, g1); SEL_ENTRY(lo1, g1, e1); }
    if (item + G < T) { SEL_DECODE(item + G, lo2, g2); SEL_ENTRY(lo2, g2, e2); }
    if (item < T) SEL_STAGE(lo1, e1);
    for (; item < T; item += G) {
        __syncthreads(); img_store<8>(img, tid, ir); __syncthreads();
        QCOPY(qf, qn);
        const int bh = lo1 >> 6, t = (int)(e1 & 0x3fffu), slot = (int)((e1 >> 14) & 3u); const bool vq = (e1 >> 16) != 0u;
        lo1 = lo2; g1 = g2; e1 = e2;
        if (item + G < T) SEL_STAGE(lo1, e1);
        if (item + 2 * G < T) { SEL_DECODE(item + 2 * G, lo2, g2); SEL_ENTRY(lo2, g2, e2); }
        const float shift = q_shift(qf, kml[bh]);
        f32x16 o0, o1; float l; AT_ZERO(o0, o1, l);
        at2_run(qf, shift, img, 0, 8, -1, -1, false, 0, 0, hi, lane, o0, o1, l);
        l += __shfl_xor(l, 32);
        const size_t row = (size_t)((bh >> 3) * SEQ + t);
        if (vq) { at_store_bf16(PO + ((row * 8 + (bh & 7)) * 3 + slot) * 64, hi, o0, o1, 1.0f); if (hi == 0) PL[(row * 8 + (bh & 7)) * 3 + slot] = l; }
    }
#undef SEL_DECODE
#undef SEL_ENTRY
#undef SEL_STAGE
}
__device__ __forceinline__ void dil_y_units(bf16* X1, const bf16* X2, const bf16* DO, const float* DL, LAS char* img, int tid, int G) {
    const int lane = tid & 63, w = __builtin_amdgcn_readfirstlane(tid >> 6), r32 = lane & 31, hi = lane >> 5;
    v4u ir[12]; bf16x8 qn[4], qf[4];
#define DY_PREFETCH(un) do { const int bh_ = (un) >> 6, S0_ = (((un) >> 4) & 3) * 4096, rr_ = (un) & 15, b_ = bh_ >> 3, h_ = bh_ & 7; \
        img_load<12>(X2 + (size_t)b_ * SEQ * 2048 + 1024 + h_ * 64, rr_ + S0_ - 2048, 16, tid, ir); \
        load_qf(X1 + (size_t)(b_ * SEQ + S0_ + rr_ + 16 * (32 * w + r32)) * KMRG + 512 + h_ * 64, hi, qn); } while (0)
    int un = blockIdx.x;
    if (un < 1024) DY_PREFETCH(un);
    for (; un < 1024; un += G) {
        __syncthreads(); img_store<12>(img, tid, ir); __syncthreads();
        QCOPY(qf, qn);
        if (un + G < 1024) DY_PREFETCH(un + G);
        const int bh = un >> 6, S0 = ((un >> 4) & 3) * 4096, rr = un & 15, b = bh >> 3, h = bh & 7, Lb = S0 >> 4;
        const float shift = q_shift(qf, ((LAS const float*)(img + KML_OFF))[16 + bh]);
        f32x16 o0, o1; float l; AT_ZERO(o0, o1, l);
        const int own = 32 * w + r32, klo = Lb == 0 ? (own > 128 ? own : 128) : own;
        at2_run(qf, shift, img, (Lb == 0 && w < 4) ? 4 : w, w + 5, w, w + 4, Lb == 0, klo, own + 128, hi, lane, o0, o1, l);
        l += __shfl_xor(l, 32);
        const size_t row = (size_t)(b * SEQ + S0 + rr + 16 * own);
        at_add_bf16<false>(DO + row * 512 + h * 64, hi, o0, o1); l += DL[row * 8 + h];
        at_store_bf16(X1 + row * KMRG + 512 + h * 64, hi, o0, o1, 1.0f / l);
    }
#undef DY_PREFETCH
}
__device__ __forceinline__ void moba_own_units(bf16* X1, const bf16* X2, const bf16* PO, const float* PL, LAS char* img, int tid, int G) {
    const int lane = tid & 63, w = __builtin_amdgcn_readfirstlane(tid >> 6), r32 = lane & 31, hi = lane >> 5;
    v4u ir[8]; bf16x8 qn[4], qf[4];
#define MO_PREFETCH(un) do { const int bh_ = (un) >> 6, n_ = (un) & 63, b_ = bh_ >> 3, h_ = bh_ & 7; \
        img_load<8>(X2 + (size_t)b_ * SEQ * 2048 + h_ * 64, 256 * n_, 1, tid, ir); \
        load_qf(X1 + (size_t)(b_ * SEQ + 256 * n_ + 32 * w + r32) * KMRG + h_ * 64, hi, qn); } while (0)
    int un = blockIdx.x;
    if (un < 1024) MO_PREFETCH(un);
    for (; un < 1024; un += G) {
        __syncthreads(); img_store<8>(img, tid, ir); __syncthreads();
        QCOPY(qf, qn);
        if (un + G < 1024) MO_PREFETCH(un + G);
        const int bh = un >> 6, n = un & 63, b = bh >> 3, h = bh & 7;
        const float shift = q_shift(qf, ((LAS const float*)(img + KML_OFF))[bh]);
        f32x16 o0, o1; float l; AT_ZERO(o0, o1, l);
        at2_run(qf, shift, img, 0, w + 1, w, -1, false, 0, 32 * w + r32, hi, lane, o0, o1, l);
        l += __shfl_xor(l, 32);
        const size_t row = (size_t)(b * SEQ + 256 * n + 32 * w + r32);
        const int nv = n < 3 ? n : 3;
        for (int s = 0; s < nv; ++s) { at_add_bf16<false>(PO + ((row * 8 + h) * 3 + s) * 64, hi, o0, o1); l += PL[(row * 8 + h) * 3 + s]; }
        at_store_bf16(X1 + row * KMRG + h * 64, hi, o0, o1, 1.0f / l);
    }
#undef MO_PREFETCH
}

constexpr int PH_PER_LAYER = 11, NPH = 1 + DEPTH * PH_PER_LAYER;
struct Args { const float* in[14]; float* out; unsigned char* ws; int ph_lo, ph_hi; };
__global__ void __launch_bounds__(NWAVES * 64, 2) fwd(Args args) {
    extern __shared__ __attribute__((aligned(16))) unsigned char lds_raw[];
    LAS unsigned char* lds = (LAS unsigned char*)lds_raw;
    const int tid = threadIdx.x;
    const int G = gridDim.x, NGW = G * NWAVES, NTH = G * NWAVES * 64;
#define CTL ((gu32*)(wsb + WS_CTL))
    unsigned char* wsb = args.ws;
    volatile LAS unsigned* MISC = (volatile LAS unsigned*)(lds + MISC_OFF);
    for (int u = tid; u < (LDS_BYTES - LDSCTL_OFF) / 4; u += NWAVES * 64) ((LAS unsigned*)(lds + LDSCTL_OFF))[u] = 0u;
    __syncthreads();
#if MK_ONE_LAUNCH
    XcdBarrier bar = xcd_barrier_post((unsigned*)(CTL + CW_BAR), MISC + 8);
#define SEAM(p) do { if ((p) + 1 < hi) xcd_barrier(bar); } while (0)
#else
#define SEAM(p) do { } while (0)
#endif
    const int lo = args.ph_lo, hi = args.ph_hi;
#if TIME_PROBE
    unsigned long long tacc_a = 0, tacc_b = 0, t_prev = __builtin_amdgcn_s_memrealtime();
#define TSTAMP(k) do { const unsigned long long now_ = __builtin_amdgcn_s_memrealtime(); if ((k) == TIME_A) tacc_a += now_ - t_prev; if ((k) == TIME_B) tacc_b += now_ - t_prev; t_prev = now_; } while (0)
#else
#define TSTAMP(k) do { } while (0)
#endif
#define IN(k) (lo <= (k) && (k) < hi)
#define PHB() int tidp = threadIdx.x; asm volatile("" : "+v"(tidp)); const int lane = tidp & 63, wave = __builtin_amdgcn_readfirstlane(tidp >> 6); const int gw = blockIdx.x * NWAVES + wave, gtid = blockIdx.x * (NWAVES * 64) + tidp; unsigned char* wsb = args.ws; asm volatile("" : "+s"(wsb)); (void)lane; (void)wave; (void)gw; (void)gtid;
#define X1 ((bf16*)(wsb + WS_X1))
#define X2 ((bf16*)(wsb + WS_X2))
#define GT (wsb + WS_G)
#define HB ((bf16*)(wsb + WS_HB))
#define UC ((bf16*)(wsb + WS_UC))
#define KBAR ((float*)(wsb + WS_KBAR))
#define MB ((bf16*)(wsb + WS_MB))
#define YB ((bf16*)(wsb + WS_Y))
#define HH ((bf16*)(wsb + WS_H))
#define Y2 ((bf16*)(wsb + WS_Y2))
#define WSP(off) (wsb + (off))

    if (IN(0)) { PHB();
        convert_layer(args.in, wsb, 0, lds, wave, lane, gw, NGW, gtid, NTH);
        for (int m = gw; m < M; m += NGW) row_norm_bf16(args.in[0] + (size_t)m * D, args.in[8], HB + (size_t)m * D, lane);
        SEAM(0); TSTAMP(11);
    }
    for (int l = 0; l < DEPTH; ++l) {
        const int pb = 1 + l * PH_PER_LAYER;
        if (IN(pb + 0)) { PHB();
            pg8::Gemm g{HB, (const bf16*)WSP(WS_WIN), M, NIN, D}; pg8::StaticOrder S; S.init(M, NIN, G, (int)blockIdx.x);
            pg8::EpiIn E{X1, UC, X2, GT};
            for (int rep_ = 0; rep_ < REP_GEMM; ++rep_) {
                pg8::gemm_phase<pg8::EpiIn, pg8::StaticOrder, PG8_ALIGN, PG8_SP2>(lds + RING_OFF, g, S, E);
            }
            SEAM(pb + 0); TSTAMP(0);
        }
        if (IN(pb + 1)) { PHB();
            for (int rep_ = 0; rep_ < REP_KP; ++rep_) {
            for (int job = gw; job < 2048; job += NGW) kstat_job2(X2, KBAR, CTL + CW_KMAX + l * 32, job, lane);
            pool_rows(UC, X1, gw, NGW, lane); }
            SEAM(pb + 1); TSTAMP(1);
        }
#if ATTN_NAIVE
        if (IN(pb + 2)) { PHB();
            for (int job = gw; job < M * NH; job += NGW) { const int tg = job >> 3, h = job & 7; nv_moba(X1, X2, KBAR, tg >> 14, tg & (SEQ - 1), h, lane); }
            for (int job = gw; job < M * NH; job += NGW) { const int tg = job >> 3, h = job & 7; nv_dil(X1, X2, tg >> 14, tg & (SEQ - 1), h, lane); }
            SEAM(pb + 2); TSTAMP(2);
        }
        if (IN(pb + 3)) { SEAM(pb + 3); TSTAMP(3); }
        if (IN(pb + 4)) { SEAM(pb + 4); TSTAMP(4); }
#else
        if (IN(pb + 2)) { PHB();
#if ATTN_CHECK
            for (int job = gw; job < 8192; job += NGW) chk_ref_job(X1, X2, KBAR, (float*)(wsb + WS_CHK), job, lane);
#endif
            for (int jx = blockIdx.x; jx < 512; jx += G) { const int cx = jx >> 4; moba_gate_job(X1, KBAR, CTL + CW_GCNT + l * 1024, (bf16*)(wsb + WS_LIST), (jx & 15) * 32 + (cx < 16 ? cx : 47 - cx), lds, tidp); }
            SEAM(pb + 2); TSTAMP(2);
        }
        if (IN(pb + 3)) { PHB();
            if (tidp < 32) ((LAS unsigned*)(lds + KML_OFF))[tidp] = __hip_atomic_load(CTL + CW_KMAX + l * 32 + tidp, RLX_AGENT);
            __syncthreads();
            for (int rep_ = 0; rep_ < REP_X; ++rep_) {
            for (int u = blockIdx.x; u < 256; u += G) dil_x_unit(X1, X2, (bf16*)(wsb + WS_DO), (float*)(wsb + WS_DL), u, (LAS char*)lds, tidp);
            TSTAMP(20);
            moba_sel_items(X1, X2, (const bf16*)(wsb + WS_LIST), (bf16*)(wsb + WS_PO), (float*)(wsb + WS_PL), CTL + CW_GCNT + l * 1024, lds, tidp, G);
            }
            SEAM(pb + 3); TSTAMP(3);
        }
        if (IN(pb + 4)) { PHB();
            if (tidp < 32) ((LAS unsigned*)(lds + KML_OFF))[tidp] = __hip_atomic_load(CTL + CW_KMAX + l * 32 + tidp, RLX_AGENT);
            __syncthreads();
            dil_y_units(X1, X2, (const bf16*)(wsb + WS_DO), (const float*)(wsb + WS_DL), (LAS char*)lds, tidp, G);
            TSTAMP(21);
            moba_own_units(X1, X2, (const bf16*)(wsb + WS_PO), (const float*)(wsb + WS_PL), (LAS char*)lds, tidp, G);
            SEAM(pb + 4); TSTAMP(4);
        }
#endif
        if (IN(pb + 5)) { PHB();
#if ATTN_CHECK
            for (int job = gw; job < 8192; job += NGW) chk_cmp_job(X1, (const float*)(wsb + WS_CHK), (float*)(wsb + WS_CTL) + CW_CHK + l * 4, job, lane);
#endif
            pg8::Gemm g{X1, (const bf16*)WSP(WS_WBR), M, D, KMRG}; pg8::StaticOrder S; S.init(M, D, G, (int)blockIdx.x);
            pg8::EpiMerge E{GT, MB};
            for (int rep_ = 0; rep_ < REP_GEMM; ++rep_) {
                pg8::gemm_phase<pg8::EpiMerge, pg8::StaticOrder, PG8_ALIGN, PG8_SP2>(lds + RING_OFF, g, S, E);
            }
            SEAM(pb + 5); TSTAMP(5);
        }
        if (IN(pb + 6)) { PHB();
            pg8::Gemm g{MB, (const bf16*)WSP(WS_WO), M, D, D}; pg8::StaticOrder S; S.init(M, D, G, (int)blockIdx.x);
            pg8::EpiPlain<0> E{YB, D};
            for (int rep_ = 0; rep_ < REP_GEMM; ++rep_) {
                pg8::gemm_phase<pg8::EpiPlain<0>, pg8::StaticOrder, PG8_ALIGN, PG8_SP2>(lds + RING_OFF, g, S, E);
            }
            SEAM(pb + 6); TSTAMP(6);
        }
        if (IN(pb + 7)) { PHB();
            const float* xi = l == 0 ? args.in[0] : (const float*)args.out;
            rows_post(YB, xi, args.out, args.in[9] + l * D, HB, args.in[10] + l * D, gw, NGW, lane);
            SEAM(pb + 7); TSTAMP(7);
        }
        if (IN(pb + 8)) { PHB();
            pg8::Gemm g{HB, (const bf16*)WSP(WS_W1), M, FF, D}; pg8::StaticOrder S; S.init(M, FF, G, (int)blockIdx.x);
            pg8::EpiPlain<1> E{HH, FF};
            for (int rep_ = 0; rep_ < REP_GEMM; ++rep_) {
                pg8::gemm_phase<pg8::EpiPlain<1>, pg8::StaticOrder, PG8_ALIGN, PG8_SP2>(lds + RING_OFF, g, S, E);
            }
            SEAM(pb + 8); TSTAMP(8);
        }
        if (IN(pb + 9)) { PHB();
            pg8::Gemm g{HH, (const bf16*)WSP(WS_W2), M, D, FF}; pg8::StaticOrder S; S.init(M, D, G, (int)blockIdx.x);
            pg8::EpiPlain<0> E{Y2, D};
            for (int rep_ = 0; rep_ < REP_GEMM; ++rep_) {
                pg8::gemm_phase<pg8::EpiPlain<0>, pg8::StaticOrder, PG8_ALIGN, PG8_SP2>(lds + RING_OFF, g, S, E);
            }
            SEAM(pb + 9); TSTAMP(9);
        }
        if (IN(pb + 10)) { PHB();
            const bool more = (l + 1 < DEPTH);
            rows_post(Y2, args.out, args.out, args.in[11] + l * D, more ? HB : (bf16*)nullptr, args.in[8] + (l + 1 < DEPTH ? l + 1 : l) * D, gw, NGW, lane);
            if (more) convert_layer(args.in, wsb, l + 1, lds, wave, lane, gw, NGW, gtid, NTH);
#if ATTN_CHECK
            if (!more) { asm volatile("s_waitcnt vmcnt(0)" ::: "memory"); float f = 1.0f;
                for (int k = 0; k < 4; ++k) { const float d2 = __builtin_bit_cast(float, __hip_atomic_load(CTL + CW_CHK + 2 * k, RLX_AGENT)), r2 = __builtin_bit_cast(float, __hip_atomic_load(CTL + CW_CHK + 2 * k + 1, RLX_AGENT)); if (CHK_SEL & (1 << k)) f += 10.0f * sqrtf(d2 / r2); }
                for (int m = gw; m < M; m += NGW) { GAS f32x4* o = (GAS f32x4*)(args.out + (size_t)m * D) + lane;
                    for (int j = 0; j < 4; ++j) o[64 * j] = o[64 * j] * f; } }
#endif
            SEAM(pb + 10); TSTAMP(10);
        }
    }
#if TIME_PROBE
    if (blockIdx.x == 0) {
        const unsigned long long until = __builtin_amdgcn_s_memrealtime() + 32ull * tacc_a + 0ull * tacc_b;
        while (__builtin_amdgcn_s_memrealtime() < until) __builtin_amdgcn_s_sleep(32);
    }
#endif
#undef IN
#undef SEAM
}

extern "C" void kernel_launch(void* const* d_in, const int* in_sizes, int n_in, void* d_out, int out_size, void* d_ws, size_t ws_size, hipStream_t stream) {
    static int grid = 0;
    if (grid == 0) {
        if (n_in != 14 || in_sizes[0] != M * D || out_size != M * D || ws_size < WS_END) { fprintf(stderr, "kernel_launch: unexpected shapes / workspace (n_in %d, in0 %d, out %d, ws %zu); nothing launched\n", n_in, n_in > 0 ? in_sizes[0] : -1, out_size, ws_size); grid = -1; return; }
        int dev = 0, cus = 0, per_cu = 0;
        if (hipGetDevice(&dev) != hipSuccess || hipDeviceGetAttribute(&cus, hipDeviceAttributeMultiprocessorCount, dev) != hipSuccess) { grid = -1; return; }
        if (hipFuncSetAttribute((const void*)fwd, hipFuncAttributeMaxDynamicSharedMemorySize, LDS_BYTES) != hipSuccess) { fprintf(stderr, "kernel_launch: hipFuncSetAttribute failed\n"); grid = -1; return; }
        if (hipOccupancyMaxActiveBlocksPerMultiprocessor(&per_cu, (const void*)fwd, NWAVES * 64, LDS_BYTES) != hipSuccess || per_cu < 1) fprintf(stderr, "kernel_launch: occupancy query reports %d workgroups per CU\n", per_cu);
        (void)hipGetLastError();
        grid = cus;
    }
    if (grid < 0) return;
    if (hipMemsetAsync((char*)d_ws + WS_CTL, 0, CTL_ZERO_BYTES, stream) != hipSuccess) return;
    Args a{};
    for (int i = 0; i < 14; ++i) a.in[i] = (const float*)d_in[i];
    a.out = (float*)d_out; a.ws = (unsigned char*)d_ws;
#if MK_ONE_LAUNCH
    a.ph_lo = 0; a.ph_hi = NPH;
    hipLaunchKernelGGL(fwd, dim3(grid), dim3(NWAVES * 64), LDS_BYTES, stream, a);
#else
    for (int p = 0; p < NPH; ++p) { a.ph_lo = p; a.ph_hi = p + 1; hipLaunchKernelGGL(fwd, dim3(grid), dim3(NWAVES * 64), LDS_BYTES, stream, a); }
#endif
}
```
